# Optimizing an MI355X kernel written in HIP

```python
import jax, jax.numpy as jnp
from jax import lax
import numpy as np


D_MODEL = 2048
BATCH = 4
SEQ = 2048
DEPTH = 2

MEM_LEN = 256
GRID_W = 64
HEAD_DIM = 128
RMS_EPS = 1e-6

NA_HEADS = 6
NA_MAX_KH = 8
NA_KW = 16
NA_W = NA_HEADS * HEAD_DIM

FN_GROUPS = 6
FN_GROUP_W = 128
FN_W = FN_GROUPS * FN_GROUP_W

DIL_PATTERNS = ((128, 1), (512, 4), (2048, 16))
DIL_GROUPS = 3
DIL_HEADS_PER_GROUP = 2
DIL_HEADS = DIL_GROUPS * DIL_HEADS_PER_GROUP
DIL_W = DIL_HEADS * HEAD_DIM
DIL_OUT_W = DIL_HEADS_PER_GROUP * HEAD_DIM
Q_BLOCK = 128
ROT_DIM = HEAD_DIM // 4
ROPE_THETA = 500000.0

MEM_HEADS = 4
MEM_HEAD_DIM = 192
MEM_W = MEM_HEADS * MEM_HEAD_DIM

IN_COLS = 3 * NA_W + 3 * DIL_W + FN_W + MEM_W
N_BRANCH = 4

D_FF = ((8 * D_MODEL // 3 + 255) // 256) * 256
N_EXPERTS = 8
TOP_K = 2
EXPERT_FF = 7 * D_MODEL // 2
N_DENSE = (DEPTH + 1) // 2
N_MOE = DEPTH // 2

kernel_name = "hybrid_natten_fnet_dilated_memory_moe_encoder"


def rms_norm(x, g):
    xf = x.astype(jnp.float32)
    y = xf * lax.rsqrt(jnp.mean(xf * xf, axis=-1, keepdims=True) + RMS_EPS)
    return (y * g.astype(jnp.float32)).astype(x.dtype)


def partial_rotary(x, pos):
    half = ROT_DIM // 2
    inv_freq = ROPE_THETA ** (-2.0 * jnp.arange(half, dtype=jnp.float32) / ROT_DIM)
    ang = pos.astype(jnp.float32)[:, None] * inv_freq[None, :]
    cos = jnp.cos(ang)[None, :, None, :]
    sin = jnp.sin(ang)[None, :, None, :]
    xf = x.astype(jnp.float32)
    x1 = xf[..., :half]
    x2 = xf[..., half:ROT_DIM]
    out = jnp.concatenate([x1 * cos - x2 * sin, x2 * cos + x1 * sin, xf[..., ROT_DIM:]], axis=-1)
    return out.astype(x.dtype)


def neighbourhood_attention(q, k, v, rpb):
    b, s, h, hd = q.shape
    rows = s // GRID_W
    kh = min(NA_MAX_KH, rows)
    row_start = np.clip(np.arange(rows) - kh // 2, 0, rows - kh)
    col_start = np.clip(np.arange(GRID_W) - NA_KW // 2, 0, GRID_W - NA_KW)
    col_idx = col_start[:, None] + np.arange(NA_KW)[None, :]
    d_row = row_start[:, None] + np.arange(kh)[None, :] - np.arange(rows)[:, None] + (NA_MAX_KH - 1)
    d_col = col_idx - np.arange(GRID_W)[:, None] + (NA_KW - 1)
    bias = rpb[:, d_row[:, :, None, None], d_col[None, None, :, :]]
    bias = bias.transpose(1, 0, 3, 2, 4).astype(jnp.float32)
    q_rows = (q * hd ** -0.5).reshape(b, rows, GRID_W, h, hd).transpose(1, 0, 2, 3, 4)
    k_grid = k.reshape(b, rows, GRID_W, h, hd)
    v_grid = v.reshape(b, rows, GRID_W, h, hd)

    def row_block(args):
        q_row, r0, b_row = args
        k_blk = lax.dynamic_slice_in_dim(k_grid, r0, kh, axis=1)[:, :, col_idx]
        v_blk = lax.dynamic_slice_in_dim(v_grid, r0, kh, axis=1)[:, :, col_idx]
        sc = jnp.einsum("bchd,bkcjhd->bhckj", q_row, k_blk).astype(jnp.float32) + b_row[None]
        p = jax.nn.softmax(sc.reshape(b, h, GRID_W, kh * NA_KW), axis=-1).reshape(sc.shape)
        return jnp.einsum("bhckj,bkcjhd->bchd", p.astype(v_blk.dtype), v_blk)

    out = lax.map(row_block, (q_rows, jnp.asarray(row_start, jnp.int32), bias))
    return out.transpose(1, 0, 2, 3, 4).reshape(b, s, h * hd)


def dilated_attention(q, k, v):
    b, s, _, hd = q.shape
    g, hg = DIL_GROUPS, DIL_HEADS_PER_GROUP
    offsets = jnp.asarray(np.stack([np.arange(-(w // (2 * d)), w // (2 * d) + 1) * d
                                    for (w, d) in DIL_PATTERNS]), jnp.int32)
    group_ix = np.arange(g)[:, None, None]
    n_blk = s // Q_BLOCK
    q_blocks = (q * hd ** -0.5).reshape(b, n_blk, Q_BLOCK, g, hg, hd).transpose(1, 0, 2, 3, 4, 5)
    k_g = k.reshape(b, s, g, hg, hd)
    v_g = v.reshape(b, s, g, hg, hd)

    def query_block(args):
        q_blk, start = args
        idx = start + jnp.arange(Q_BLOCK, dtype=jnp.int32)[None, :, None] + offsets[:, None, :]
        valid = (idx >= 0) & (idx < s)
        idx = jnp.clip(idx, 0, s - 1)
        k_sel = k_g[:, idx, group_ix]
        v_sel = v_g[:, idx, group_ix]
        sc = jnp.einsum("bqghd,bgqjhd->bghqj", q_blk, k_sel).astype(jnp.float32)
        sc = jnp.where(valid[None, :, None], sc, -jnp.inf)
        lse = jax.nn.logsumexp(sc, axis=-1)
        p = jnp.exp(sc - lse[..., None])
        o = jnp.einsum("bghqj,bgqjhd->bghqd", p.astype(v_sel.dtype), v_sel)
        w_grp = jax.nn.softmax(lse, axis=1)
        return jnp.einsum("bghq,bghqd->bqhd", w_grp.astype(o.dtype), o)

    starts = jnp.arange(n_blk, dtype=jnp.int32) * Q_BLOCK
    out = lax.map(query_block, (q_blocks, starts))
    return out.transpose(1, 0, 2, 3, 4).reshape(b, s, hg * hd)


def fourier_mix(u):
    b, s, _ = u.shape
    ug = u.astype(jnp.float32).reshape(b, s, FN_GROUPS, FN_GROUP_W)
    f = jnp.fft.fft2(ug, axes=(1, 3), norm="ortho")
    return jnp.real(f).reshape(b, s, FN_W).astype(u.dtype)


def memory_attention(q, k, v):
    sc = jnp.einsum("bshd,bmhd->bhsm", q * MEM_HEAD_DIM ** -0.5, k).astype(jnp.float32)
    p = jax.nn.softmax(sc, axis=-1)
    o = jnp.einsum("bhsm,bmhd->bshd", p.astype(v.dtype), v)
    return o.reshape(q.shape[0], q.shape[1], MEM_W)


def hybrid_mixer(h, mem_n, pos, w_in, rpb, w_mem_kv, w_br_a, w_br_b, w_br_c, w_br_m, w_gate, b_gate, w_out):
    b, s, d = h.shape
    z = h @ w_in
    splits = [int(c) for c in np.cumsum([NA_W] * 3 + [DIL_W] * 3 + [FN_W])]
    qa, ka, va, qc, kc, vc, ub, qm = jnp.split(z, splits, axis=-1)
    heads = lambda t, n, dh: t.reshape(t.shape[0], t.shape[1], n, dh)
    y_a = neighbourhood_attention(heads(qa, NA_HEADS, HEAD_DIM), heads(ka, NA_HEADS, HEAD_DIM),
                                  heads(va, NA_HEADS, HEAD_DIM), rpb)
    y_b = fourier_mix(ub)
    y_c = dilated_attention(partial_rotary(heads(qc, DIL_HEADS, HEAD_DIM), pos),
                            partial_rotary(heads(kc, DIL_HEADS, HEAD_DIM), pos),
                            heads(vc, DIL_HEADS, HEAD_DIM))
    kv = mem_n @ w_mem_kv
    km, vm = jnp.split(kv, 2, axis=-1)
    y_m = memory_attention(heads(qm, MEM_HEADS, MEM_HEAD_DIM), heads(km, MEM_HEADS, MEM_HEAD_DIM),
                           heads(vm, MEM_HEADS, MEM_HEAD_DIM))
    gates = jax.nn.sigmoid((h @ w_gate + b_gate).astype(jnp.float32)).astype(h.dtype).reshape(b, s, N_BRANCH, d)
    merged = (gates[:, :, 0] * (y_a @ w_br_a) + gates[:, :, 1] * (y_b @ w_br_b)
              + gates[:, :, 2] * (y_c @ w_br_c) + gates[:, :, 3] * (y_m @ w_br_m))
    return merged @ w_out


def swiglu(t, wg, wu, wd):
    return (jax.nn.silu(t @ wg) * (t @ wu)) @ wd


def moe_swiglu(h, router, wg, wu, wd):
    b, s, d = h.shape
    t = h.reshape(b * s, d)
    logits = (t @ router).astype(jnp.float32)
    top_v, top_i = lax.top_k(logits, TOP_K)
    gate = jax.nn.softmax(top_v, axis=-1)
    combine = jnp.sum(jax.nn.one_hot(top_i, N_EXPERTS, dtype=jnp.float32) * gate[..., None], axis=1)
    combine = combine.astype(t.dtype)
    out = jnp.zeros_like(t)
    for e in range(N_EXPERTS):
        out = out + combine[:, e:e + 1] * swiglu(t, wg[e], wu[e], wd[e])
    return out.reshape(b, s, d)


def setup_inputs(seed: int = 0) -> dict:
    key = jax.random.key(seed)
    ks = jax.random.split(key, 24)
    f32 = jnp.float32
    D = D_MODEL

    def nrm(k, shape, scale):
        return jax.random.normal(k, shape, f32) * scale

    def gain(k, shape):
        return 1.0 + 0.05 * jax.random.normal(k, shape, f32)

    return {
        "x": nrm(ks[0], (BATCH, SEQ, D), 1.0),
        "mem": nrm(ks[1], (BATCH, MEM_LEN, D), 1.0),
        "norm_mix": gain(ks[2], (DEPTH, D)),
        "w_in": nrm(ks[3], (DEPTH, D, IN_COLS), D ** -0.5),
        "rpb": nrm(ks[4], (DEPTH, NA_HEADS, 2 * NA_MAX_KH - 1, 2 * NA_KW - 1), 0.1),
        "norm_mem": gain(ks[5], (DEPTH, D)),
        "w_mem_kv": nrm(ks[6], (DEPTH, D, 2 * MEM_W), D ** -0.5),
        "w_br_a": nrm(ks[7], (DEPTH, NA_W, D), NA_W ** -0.5),
        "w_br_b": nrm(ks[8], (DEPTH, FN_W, D), FN_W ** -0.5),
        "w_br_c": nrm(ks[9], (DEPTH, DIL_OUT_W, D), DIL_OUT_W ** -0.5),
        "w_br_m": nrm(ks[10], (DEPTH, MEM_W, D), MEM_W ** -0.5),
        "w_gate": nrm(ks[11], (DEPTH, D, N_BRANCH * D), D ** -0.5),
        "b_gate": nrm(ks[12], (DEPTH, N_BRANCH * D), 0.1),
        "w_out": nrm(ks[13], (DEPTH, D, D), D ** -0.5),
        "norm_ffn": gain(ks[14], (DEPTH, D)),
        "dense_w_gate": nrm(ks[15], (N_DENSE, D, D_FF), D ** -0.5),
        "dense_w_up": nrm(ks[16], (N_DENSE, D, D_FF), D ** -0.5),
        "dense_w_down": nrm(ks[17], (N_DENSE, D_FF, D), D_FF ** -0.5),
        "router": nrm(ks[18], (N_MOE, D, N_EXPERTS), D ** -0.5),
        "exp_w_gate": nrm(ks[19], (N_MOE, N_EXPERTS, D, EXPERT_FF), D ** -0.5),
        "exp_w_up": nrm(ks[20], (N_MOE, N_EXPERTS, D, EXPERT_FF), D ** -0.5),
        "exp_w_down": nrm(ks[21], (N_MOE, N_EXPERTS, EXPERT_FF, D), EXPERT_FF ** -0.5),
        "final_norm": gain(ks[22], (D,)),
    }


def reference(x, mem, norm_mix, w_in, rpb, norm_mem, w_mem_kv, w_br_a, w_br_b, w_br_c, w_br_m,
              w_gate, b_gate, w_out, norm_ffn, dense_w_gate, dense_w_up, dense_w_down,
              router, exp_w_gate, exp_w_up, exp_w_down, final_norm):
    pos = jnp.arange(x.shape[1], dtype=jnp.int32)
    for layer in range(DEPTH):
        h = rms_norm(x, norm_mix[layer])
        mem_n = rms_norm(mem, norm_mem[layer])
        x = x + hybrid_mixer(h, mem_n, pos, w_in[layer], rpb[layer], w_mem_kv[layer],
                             w_br_a[layer], w_br_b[layer], w_br_c[layer], w_br_m[layer],
                             w_gate[layer], b_gate[layer], w_out[layer])
        h = rms_norm(x, norm_ffn[layer])
        i = layer // 2
        if layer % 2 == 0:
            x = x + swiglu(h, dense_w_gate[i], dense_w_up[i], dense_w_down[i])
        else:
            x = x + moe_swiglu(h, router[i], exp_w_gate[i], exp_w_up[i], exp_w_down[i])
    return rms_norm(x, final_norm)
```

```cpp
#include <hip/hip_runtime.h>
#include <cstdio>
#include <cstdint>

#ifndef N_LAUNCHES
#define N_LAUNCHES 1
#endif

#define LAS __attribute__((address_space(3)))
#define GAS __attribute__((address_space(1)))
#define AS_GLOBAL(T, p) ((T)(GAS T)(p))
typedef unsigned short bf16_t;
typedef short bf16x8 __attribute__((ext_vector_type(8)));
typedef short s16x4 __attribute__((ext_vector_type(4)));
typedef float f32x2 __attribute__((ext_vector_type(2)));
typedef float f32x4 __attribute__((ext_vector_type(4)));
typedef float f32x16 __attribute__((ext_vector_type(16)));
typedef unsigned u32x2 __attribute__((ext_vector_type(2)));
typedef unsigned u32x4 __attribute__((ext_vector_type(4)));
typedef __bf16 nbf16x2 __attribute__((ext_vector_type(2)));

__device__ __forceinline__ unsigned pk2(float a, float b) { f32x2 v = {a, b}; nbf16x2 r = __builtin_convertvector(v, nbf16x2); return __builtin_bit_cast(unsigned, r); }
__device__ __forceinline__ float bf_lo(unsigned w) { return __uint_as_float(w << 16); }
__device__ __forceinline__ float bf_hi(unsigned w) { return __uint_as_float(w & 0xffff0000u); }
#define LDS_WAIT() asm volatile("s_waitcnt lgkmcnt(0)" ::: "memory")
#define VM_WAIT() asm volatile("s_waitcnt vmcnt(0)" ::: "memory")

constexpr int T = 8192, D = 2048, SEQ = 2048, NB = 4, MEML = 256;
constexpr int DFF = 5632, EFF = 7168, NEXP = 8;
constexpr int ZC = 3840;
constexpr int SWR = 3072;
constexpr float RMS_EPS = 1e-6f;
constexpr int NWAVES = 8, NTHREADS = 512;

constexpr size_t MiB = 1u << 20;
constexpr size_t WS_CTL = 0, CTL_ZERO_BYTES = 1 * MiB;
constexpr size_t WS_TAB = 1 * MiB;
constexpr size_t WS_TOKE = WS_TAB + 256 * 1024;
constexpr size_t WS_TOKW = WS_TOKE + 64 * 1024;
constexpr size_t WS_TOKS = WS_TOKW + 64 * 1024;
constexpr size_t WS_RANK = WS_TOKS + 64 * 1024;
constexpr size_t WS_DFT = 2 * MiB;
constexpr size_t WS_X = 18 * MiB;
constexpr size_t WS_H = 82 * MiB;
constexpr size_t WS_MEMN = 114 * MiB;
constexpr size_t WS_WIN = 122 * MiB;
constexpr size_t WS_WS = 152 * MiB;
constexpr size_t WS_WG = 176 * MiB;
constexpr size_t WS_WMEM = 240 * MiB;
constexpr size_t WS_WBR = 252 * MiB;
constexpr size_t WS_WO = 272 * MiB;
constexpr size_t WS_DGU = 288 * MiB;
constexpr size_t WS_DD = 332 * MiB;
constexpr size_t WS_EGU = 354 * MiB;
constexpr size_t WS_ED = 802 * MiB;
constexpr size_t WS_Z = 1026 * MiB;
constexpr size_t WS_VT = 1086 * MiB;
constexpr size_t WS_UT = 1110 * MiB;
constexpr size_t WS_G = 1134 * MiB;
constexpr size_t WS_KM = 1262 * MiB;
constexpr size_t WS_VMT = 1264 * MiB;
constexpr size_t WS_YA = 1266 * MiB, WS_YB = 1278 * MiB, WS_YC = 1290 * MiB, WS_YM = 1294 * MiB;
constexpr size_t WS_MP = 1306 * MiB;
constexpr size_t WS_MG = 1370 * MiB;
constexpr size_t WS_ACT = 1402 * MiB;
constexpr size_t WS_HA = 1026 * MiB;
constexpr size_t WS_EACT = 1091 * MiB;
constexpr size_t WS_OS = 1319 * MiB;
constexpr size_t WS_END = 1490 * MiB;
static_assert(WS_HA + (size_t)16640 * 2048 * 2 <= WS_EACT && WS_EACT + (size_t)16640 * 7168 * 2 <= WS_OS && WS_OS + (size_t)16384 * 2048 * 4 <= WS_END, "moe map");

constexpr int CW_TMO = 0, CW_CODE = 1;
constexpr int CW_BAR = 4096;
constexpr int CW_Q = 8192;
constexpr int CW_MOE = 12288;

constexpr int RING_BYTES = 131072;
constexpr int XTAB_OFF = RING_BYTES;
constexpr int MISC_OFF = XTAB_OFF + 11264;
constexpr int UTAB_OFF = MISC_OFF + 256;
constexpr int LDS_BYTES = 147456;
static_assert(UTAB_OFF + 2048 <= LDS_BYTES, "lds");

#define XB_TMO      128
#define XB_XCNT(j)  (256  + 64 * (j))
#define XB_XSUB(j)  (1280 + 64 * (j))
#define XB_XGEN(j)  (2304 + 64 * (j))
#define XB_TOP      3328
#define XB_TOPGEN   3392
#define XCD_BAR_WORDS 3456
#define XB_SPIN_CAP (1u << 18)
__device__ __forceinline__ unsigned xb_ld(unsigned* p)              { return __hip_atomic_load(p, __ATOMIC_RELAXED, __HIP_MEMORY_SCOPE_AGENT); }
__device__ __forceinline__ unsigned xb_add(unsigned* p, unsigned v) { return __hip_atomic_fetch_add(p, v, __ATOMIC_RELAXED, __HIP_MEMORY_SCOPE_AGENT); }
__device__ __forceinline__ unsigned xb_xcc_id() { return (unsigned)__builtin_amdgcn_s_getreg((3 << 11) | 20) & 0xFu; }
#define XB_SPIN(cond, bar) do { unsigned _sp = 0; while (cond) { __builtin_amdgcn_s_sleep(1); \
    if ((++_sp & 255u) == 0u) { if (xb_ld(&(bar)[XB_TMO])) break; if (_sp > XB_SPIN_CAP) { atomicAdd(&(bar)[XB_TMO], 1u); break; } } } } while (0)
struct XcdBarrier { unsigned* bar; unsigned x; volatile LAS unsigned* st; };
__device__ __forceinline__ XcdBarrier xcd_barrier_post(unsigned* bar, volatile LAS unsigned* st) {
    XcdBarrier b; b.bar = bar; b.x = xb_xcc_id(); b.st = st;
    if (threadIdx.x == 0) (void)xb_add(&bar[XB_XCNT(b.x)], 1u);
    return b;
}
__device__ __forceinline__ void xcd_barrier_complete(unsigned* bar, unsigned x, unsigned& nloc, unsigned& nx) {
    const unsigned G = gridDim.x * gridDim.y * gridDim.z;
    unsigned sum, cnt, mine, sp = 0u;
    for (;;) {
        sum = 0u; cnt = 0u; mine = 0u;
#pragma unroll
        for (unsigned j = 0; j < 16; ++j) { const unsigned c = xb_ld(&bar[XB_XCNT(j)]); sum += c; cnt += (c > 0u) ? 1u : 0u; mine = (j == x) ? c : mine; }
        if (sum == G) break;
        __builtin_amdgcn_s_sleep(1);
        if ((++sp & 255u) == 0u) { if (xb_ld(&bar[XB_TMO])) break; if (sp > XB_SPIN_CAP) { atomicAdd(&bar[XB_TMO], 1u); break; } }
    }
    nloc = mine > 0u ? mine : 1u; nx = cnt > 0u ? cnt : 1u;
}
__device__ __forceinline__ void xcd_barrier(const XcdBarrier& b) {
    asm volatile("s_waitcnt vmcnt(0)" ::: "memory");
    __syncthreads();
    if (threadIdx.x == 0) {
        unsigned* bar = b.bar;
        __builtin_amdgcn_s_waitcnt(0);
        unsigned nloc = b.st[0], nx = b.st[1];
        if (nloc == 0u) { xcd_barrier_complete(bar, b.x, nloc, nx); b.st[0] = nloc; b.st[1] = nx; }
        const unsigned old = xb_add(&bar[XB_XSUB(b.x)], 1u);
        const unsigned gen = old / nloc;
        if (old + 1u == (gen + 1u) * nloc) {
            __builtin_amdgcn_fence(__ATOMIC_RELEASE, "agent");
            asm volatile("s_waitcnt vmcnt(0)" ::: "memory");
            const unsigned og = xb_add(&bar[XB_TOP], 1u);
            const unsigned tg = og / nx;
            if (og + 1u == (tg + 1u) * nx) xb_add(&bar[XB_TOPGEN], 1u);
            else XB_SPIN(xb_ld(&bar[XB_TOPGEN]) == tg, bar);
            __builtin_amdgcn_fence(__ATOMIC_ACQUIRE, "agent");
            xb_add(&bar[XB_XGEN(b.x)], 1u);
            asm volatile("s_waitcnt vmcnt(0)" ::: "memory");
        } else {
            XB_SPIN(xb_ld(&bar[XB_XGEN(b.x)]) == gen, bar);
            __builtin_amdgcn_fence(__ATOMIC_ACQUIRE, "agent");
            asm volatile("s_waitcnt vmcnt(0)" ::: "memory");
        }
    }
    __syncthreads();
}

namespace g8 {
constexpr int BM = 256, BK = 64, HALF = 128, HTB = HALF * BK * 2, STAGE_BYTES = 8 * HTB;
__host__ __device__ __forceinline__ int lds_byte(int r, int c) { const int st = (r >> 4) * 2 + (c >> 5), rr = r & 15, cc = c & 31, ob = rr * 64 + cc * 2; return st * 1024 + (ob ^ (((ob >> 9) & 1) << 5)); }
__host__ __device__ __forceinline__ void stage_rc(int b, int& R, int& C) { const int st = b / 1024, sb = b % 1024, swz = sb ^ (((sb >> 9) & 1) << 5); R = (st >> 1) * 16 + swz / 64; C = (st & 1) * 32 + (swz % 64) / 2; }
__host__ __device__ __forceinline__ int perm32(int rho) { const int n = rho >> 4, i = rho & 15; return 8 * (i >> 2) + 4 * n + (i & 3); }

struct Unit { const char* A; const char* B; char* O; unsigned lda2, ldb2; int ldc; int nt; int kind; int row0, col0, lim; };

__device__ __forceinline__ void tile_map(int L, int nM, int nN, int& pm, int& pn) {
    const int nwg = nM * nN; const int q = nwg / 8, r = nwg % 8, xcd = L % 8, off = L / 8;
    const int wgid = (xcd < r ? xcd * (q + 1) : r * (q + 1) + (xcd - r) * q) + off;
    const int nig = 8 * nN, gid = wgid / nig, fm = gid * 8, gsz = (nM - fm) < 8 ? (nM - fm) : 8;
    pm = fm + ((wgid % nig) % gsz); pn = (wgid % nig) / gsz;
}

template <class Epi, class Sched>
__device__ __forceinline__ void gemm_phase(LAS unsigned char* lds, const Sched& S, const Epi& E) {
    const int tid = threadIdx.x, wid = __builtin_amdgcn_readfirstlane(tid >> 6), lane = tid & 63, wr = wid >> 2, wc = wid & 3, fr = lane & 15, fq = lane >> 4;
    unsigned spk[2];
#pragma unroll
    for (int i = 0; i < 2; ++i) { int R, C; stage_rc(tid * 16 + i * 8192, R, C); const int Rb = Epi::PERM ? ((R & ~31) + perm32(R & 31)) : R; spk[i] = (unsigned)R | ((unsigned)Rb << 8) | ((unsigned)(C * 2) << 16); }
    const unsigned ldsw = (unsigned)wid * 1024u;
    const int aoff = lds_byte(wr * 64 + fr, fq * 8), boff = lds_byte(wc * 32 + fr, fq * 8);
#define PG8_SA(b, h) (((b) * 2 + (h)) * HTB)
#define PG8_SB(b, h) ((4 + (b) * 2 + (h)) * HTB)
#define PG8_STAGE(bufoff, gbase, voff) do { _Pragma("unroll") for (int _i = 0; _i < 2; ++_i) \
        __builtin_amdgcn_global_load_lds((const unsigned*)((const char*)(gbase) + (voff)[_i]), (LAS unsigned*)(lds + (bufoff) + ldsw + _i * 8192), 16, 0, 0); } while (0)
#define PG8_LDA(dst, b, h) do { _Pragma("unroll") for (int m = 0; m < 4; ++m) _Pragma("unroll") for (int k = 0; k < 2; ++k) dst[m][k] = *(const LAS bf16x8*)(lds + PG8_SA(b, h) + aoff + m * 2048 + k * 1024); } while (0)
#define PG8_LDB(dst, b, h) do { _Pragma("unroll") for (int n = 0; n < 2; ++n) _Pragma("unroll") for (int k = 0; k < 2; ++k) dst[n][k] = *(const LAS bf16x8*)(lds + PG8_SB(b, h) + boff + n * 2048 + k * 1024); } while (0)
#define PG8_MMA(ai, bj, At, Bt) do { __builtin_amdgcn_s_setprio(1); _Pragma("unroll") for (int m = 0; m < 4; ++m) _Pragma("unroll") for (int n = 0; n < 2; ++n) _Pragma("unroll") for (int k = 0; k < 2; ++k) \
        acc[ai][bj][m][n] = __builtin_amdgcn_mfma_f32_16x16x32_bf16(Bt[n][k], At[m][k], acc[ai][bj][m][n], 0, 0, 0); __builtin_amdgcn_s_setprio(0); } while (0)
#define PG8_WAIT_V(n) asm volatile("s_waitcnt vmcnt(" #n ")" ::: "memory")
#define PG8_WAIT_L(n) asm volatile("s_waitcnt lgkmcnt(" #n ")" ::: "memory")
#define PG8_BAR __builtin_amdgcn_s_barrier()
#define PG8_SCHED __builtin_amdgcn_sched_barrier(0)
#define PG8_SETV(u_) do { _Pragma("unroll") for (int _i = 0; _i < 2; ++_i) { vA[_i] = (spk[_i] & 255u) * (u_).lda2 + (spk[_i] >> 16); vB[_i] = ((spk[_i] >> 8) & 255u) * (u_).ldb2 + (spk[_i] >> 16); } } while (0)
    int ui = 0, nt;
    const char *uA, *uB; unsigned hA, hB; unsigned vA[2], vB[2];
    { Unit u0; if (!S.next(0, u0)) return; uA = u0.A; uB = u0.B; hA = HALF * u0.lda2; hB = HALF * u0.ldb2; nt = u0.nt; PG8_SETV(u0); }
    f32x4 acc[2][2][4][2];
#pragma unroll
    for (int a = 0; a < 2; ++a)
#pragma unroll
        for (int b = 0; b < 2; ++b)
#pragma unroll
            for (int m = 0; m < 4; ++m)
#pragma unroll
                for (int n = 0; n < 2; ++n) acc[a][b][m][n] = (f32x4){0.f, 0.f, 0.f, 0.f};
    bf16x8 At[4][2], B0[2][2], B1[2][2];
    const size_t kstep = (size_t)(BK * 2);
    PG8_STAGE(PG8_SB(0, 0), uB, vB); PG8_STAGE(PG8_SB(0, 1), uB + hB, vB); PG8_STAGE(PG8_SA(0, 0), uA, vA); PG8_STAGE(PG8_SA(0, 1), uA + hA, vA);
    if (wr == 1) PG8_BAR;
    PG8_WAIT_V(2); PG8_BAR;
    PG8_STAGE(PG8_SB(1, 0), uB + kstep, vB); PG8_STAGE(PG8_SA(1, 0), uA + kstep, vA); PG8_STAGE(PG8_SB(1, 1), uB + hB + kstep, vB);
    PG8_WAIT_V(6); PG8_BAR;
    for (;;) {
        bool has_next = false; int nnt = nt;
        for (int t = 0; t < nt; t += 2) {
            const bool last = (t == nt - 2);
            PG8_LDB(B0, 0, 0); PG8_LDB(B1, 0, 1); PG8_SCHED; PG8_LDA(At, 0, 0); PG8_STAGE(PG8_SA(1, 1), uA + (size_t)(t + 1) * kstep + hA, vA);
            PG8_WAIT_V(8); PG8_WAIT_L(0); PG8_BAR; PG8_MMA(0, 0, At, B0); PG8_MMA(0, 1, At, B1); PG8_BAR; PG8_SCHED;
            const char *a2, *b2;
            if (last) { Unit nx; has_next = S.next(ui + 1, nx); if (has_next) { uA = nx.A; uB = nx.B; hA = HALF * nx.lda2; hB = HALF * nx.ldb2; nnt = nx.nt; PG8_SETV(nx); } a2 = uA; b2 = uB; }
            else { a2 = uA + (size_t)(t + 2) * kstep; b2 = uB + (size_t)(t + 2) * kstep; }
            const char* a3 = a2 + kstep; const char* b3 = b2 + kstep;
            PG8_LDA(At, 0, 1); PG8_STAGE(PG8_SB(0, 0), b2, vB); PG8_STAGE(PG8_SB(0, 1), b2 + hB, vB); PG8_STAGE(PG8_SA(0, 0), a2, vA);
            PG8_WAIT_V(8); PG8_WAIT_L(0); PG8_BAR; PG8_MMA(1, 0, At, B0); PG8_MMA(1, 1, At, B1); PG8_BAR; PG8_SCHED;
            PG8_LDB(B0, 1, 0); PG8_LDB(B1, 1, 1); PG8_SCHED; PG8_LDA(At, 1, 0); PG8_STAGE(PG8_SA(0, 1), a2 + hA, vA);
            PG8_WAIT_V(8); PG8_WAIT_L(0); PG8_BAR; PG8_MMA(0, 0, At, B0); PG8_MMA(0, 1, At, B1); PG8_BAR; PG8_SCHED;
            PG8_LDA(At, 1, 1); PG8_STAGE(PG8_SB(1, 0), b3, vB); PG8_STAGE(PG8_SB(1, 1), b3 + hB, vB); PG8_STAGE(PG8_SA(1, 0), a3, vA);
            PG8_WAIT_V(8); PG8_WAIT_L(0); PG8_BAR; PG8_MMA(1, 0, At, B0); PG8_MMA(1, 1, At, B1); PG8_BAR; PG8_SCHED;
        }
        if (wr == 0) PG8_BAR;
        { Unit eu; (void)S.next(ui, eu); int ln = lane; asm volatile("" : "+v"(ln));
          E(acc, eu, wr, wc, ln & 15, ln >> 4); }
        if (!has_next) break;
#pragma unroll
        for (int a = 0; a < 2; ++a)
#pragma unroll
            for (int b = 0; b < 2; ++b)
#pragma unroll
                for (int m = 0; m < 4; ++m)
#pragma unroll
                    for (int n = 0; n < 2; ++n) acc[a][b][m][n] = (f32x4){0.f, 0.f, 0.f, 0.f};
        ++ui; nt = nnt;
        if (wr == 1) PG8_BAR;
    }
    PG8_WAIT_V(0);
    PG8_BAR;
#undef PG8_SETV
#undef PG8_SA
#undef PG8_SB
#undef PG8_STAGE
#undef PG8_LDA
#undef PG8_LDB
#undef PG8_MMA
#undef PG8_WAIT_V
#undef PG8_WAIT_L
#undef PG8_BAR
#undef PG8_SCHED
}
}
using g8::Unit;

enum { K_PLAIN = 0, K_ZROT = 1, K_GATE = 2 };

struct EpiP1 {
    static constexpr bool PERM = true;
    const float* bgate; const f32x2* rope;
    __device__ __forceinline__ void operator()(const f32x4 (&acc)[2][2][4][2], const Unit& u, int wr, int wc, int fr, int fq) const {
        const int kind = u.kind; const int ldc = u.ldc;
        bf16_t* O = (bf16_t*)u.O;
        const bool rot = (kind == K_ZROT) && (wc == 0);
#pragma unroll
        for (int ai = 0; ai < 2; ++ai)
#pragma unroll
            for (int m = 0; m < 4; ++m) {
                const int r = ai * 128 + wr * 64 + m * 16 + fr;
                bf16_t* rowp = O + (size_t)r * ldc + wc * 32 + 8 * fq;
                f32x4 cs0[2], cs1[2];
                if (rot) { const int pos = (u.row0 + r) & (SEQ - 1); const f32x4* rp = (const f32x4*)(rope + pos * 16 + 8 * (fq & 1)); cs0[0] = rp[0]; cs0[1] = rp[1]; cs1[0] = rp[2]; cs1[1] = rp[3]; }
#pragma unroll
                for (int bj = 0; bj < 2; ++bj) {
                    f32x4 v0 = acc[ai][bj][m][0], v1 = acc[ai][bj][m][1];
                    if (kind == K_GATE) {
                        const float* bp = bgate + u.col0 + bj * 128 + wc * 32 + 8 * fq;
                        const f32x4 b0 = *(const f32x4*)bp, b1 = *(const f32x4*)(bp + 4);
#pragma unroll
                        for (int j = 0; j < 4; ++j) { v0[j] = __builtin_amdgcn_rcpf(1.f + __builtin_amdgcn_exp2f(-(v0[j] + b0[j]) * 1.44269504f)); v1[j] = __builtin_amdgcn_rcpf(1.f + __builtin_amdgcn_exp2f(-(v1[j] + b1[j]) * 1.44269504f)); }
                    }
                    if (rot) {
                        f32x4 p0, p1;
#pragma unroll
                        for (int j = 0; j < 4; ++j) { p0[j] = __shfl_xor(v0[j], 32); p1[j] = __shfl_xor(v1[j], 32); }
                        const float c00 = cs0[0][0], s00 = cs0[0][1], c01 = cs0[0][2], s01 = cs0[0][3], c02 = cs0[1][0], s02 = cs0[1][1], c03 = cs0[1][2], s03 = cs0[1][3];
                        const float c10 = cs1[0][0], s10 = cs1[0][1], c11 = cs1[0][2], s11 = cs1[0][3], c12 = cs1[1][0], s12 = cs1[1][1], c13 = cs1[1][2], s13 = cs1[1][3];
                        const float sg = (fq < 2) ? -1.f : 1.f;
                        v0[0] = v0[0] * c00 + sg * p0[0] * s00; v0[1] = v0[1] * c01 + sg * p0[1] * s01; v0[2] = v0[2] * c02 + sg * p0[2] * s02; v0[3] = v0[3] * c03 + sg * p0[3] * s03;
                        v1[0] = v1[0] * c10 + sg * p1[0] * s10; v1[1] = v1[1] * c11 + sg * p1[1] * s11; v1[2] = v1[2] * c12 + sg * p1[2] * s12; v1[3] = v1[3] * c13 + sg * p1[3] * s13;
                    }
                    u32x4 w; w.x = pk2(v0[0], v0[1]); w.y = pk2(v0[2], v0[3]); w.z = pk2(v1[0], v1[1]); w.w = pk2(v1[2], v1[3]);
                    *(u32x4*)(rowp + bj * 128) = w;
                }
            }
    }
};

struct EpiPlain {
    static constexpr bool PERM = true;
    __device__ __forceinline__ void operator()(const f32x4 (&acc)[2][2][4][2], const Unit& u, int wr, int wc, int fr, int fq) const {
        bf16_t* O = (bf16_t*)u.O; const int ldc = u.ldc;
#pragma unroll
        for (int ai = 0; ai < 2; ++ai)
#pragma unroll
            for (int m = 0; m < 4; ++m) {
                bf16_t* rowp = O + (size_t)(ai * 128 + wr * 64 + m * 16 + fr) * ldc + wc * 32 + 8 * fq;
#pragma unroll
                for (int bj = 0; bj < 2; ++bj) { const f32x4 v0 = acc[ai][bj][m][0], v1 = acc[ai][bj][m][1];
                    u32x4 w; w.x = pk2(v0[0], v0[1]); w.y = pk2(v0[2], v0[3]); w.z = pk2(v1[0], v1[1]); w.w = pk2(v1[2], v1[3]); *(u32x4*)(rowp + bj * 128) = w; }
            }
    }
};

struct EpiBranch {
    static constexpr bool PERM = true;
    const bf16_t* G; float* MP; bf16_t* MG;
    __device__ __forceinline__ void operator()(const f32x4 (&acc)[2][2][4][2], const Unit& u, int wr, int wc, int fr, int fq) const {
        const int seg = u.kind;
#pragma unroll
        for (int ai = 0; ai < 2; ++ai)
#pragma unroll
            for (int m = 0; m < 4; ++m) {
                const int r = u.row0 + ai * 128 + wr * 64 + m * 16 + fr;
#pragma unroll
                for (int bj = 0; bj < 2; ++bj) {
                    const int c = u.col0 + bj * 128 + wc * 32 + 8 * fq;
                    const u32x4 g = *(const u32x4*)(G + (size_t)r * 8192 + seg * 2048 + c);
                    f32x4 v0 = acc[ai][bj][m][0], v1 = acc[ai][bj][m][1];
                    v0[0] *= bf_lo(g.x); v0[1] *= bf_hi(g.x); v0[2] *= bf_lo(g.y); v0[3] *= bf_hi(g.y);
                    v1[0] *= bf_lo(g.z); v1[1] *= bf_hi(g.z); v1[2] *= bf_lo(g.w); v1[3] *= bf_hi(g.w);
                    float* mp = MP + (size_t)r * D + c;
                    if (seg > 0) { v0 += *(const f32x4*)mp; v1 += *(const f32x4*)(mp + 4); }
                    if (seg < 3) { *(f32x4*)mp = v0; *(f32x4*)(mp + 4) = v1; }
                    else { u32x4 w; w.x = pk2(v0[0], v0[1]); w.y = pk2(v0[2], v0[3]); w.z = pk2(v1[0], v1[1]); w.w = pk2(v1[2], v1[3]); *(u32x4*)(MG + (size_t)r * D + c) = w; }
                }
            }
    }
};

struct EpiResid {
    static constexpr bool PERM = false;
    const float* Xin; float* Xout; int ldc;
    __device__ __forceinline__ void operator()(const f32x4 (&acc)[2][2][4][2], const Unit& u, int wr, int wc, int fr, int fq) const {
#pragma unroll
        for (int ai = 0; ai < 2; ++ai)
#pragma unroll
            for (int m = 0; m < 4; ++m) {
                const int r = u.row0 + ai * 128 + wr * 64 + m * 16 + fr;
                if (r < u.lim) {
#pragma unroll
                    for (int bj = 0; bj < 2; ++bj)
#pragma unroll
                        for (int n = 0; n < 2; ++n) {
                            const size_t off = (size_t)r * ldc + u.col0 + bj * 128 + wc * 32 + n * 16 + 4 * fq;
                            f32x4 v = acc[ai][bj][m][n];
                            if (Xin) v += *(const f32x4*)(Xin + off);
                            *(f32x4*)(Xout + off) = v;
                        }
                }
            }
    }
};

struct EpiSwiglu {
    static constexpr bool PERM = true;
    bf16_t* ACT; int ldc;
    __device__ __forceinline__ void operator()(const f32x4 (&acc)[2][2][4][2], const Unit& u, int wr, int wc, int fr, int fq) const {
#pragma unroll
        for (int ai = 0; ai < 2; ++ai)
#pragma unroll
            for (int m = 0; m < 4; ++m) {
                const int r = u.row0 + ai * 128 + wr * 64 + m * 16 + fr;
                float o[8];
#pragma unroll
                for (int n = 0; n < 2; ++n)
#pragma unroll
                    for (int j = 0; j < 4; ++j) { const float g = acc[ai][0][m][n][j], uu = acc[ai][1][m][n][j]; o[n * 4 + j] = g * __builtin_amdgcn_rcpf(1.f + __builtin_amdgcn_exp2f(-g * 1.44269504f)) * uu; }
                if (r < u.lim) { u32x4 w; w.x = pk2(o[0], o[1]); w.y = pk2(o[2], o[3]); w.z = pk2(o[4], o[5]); w.w = pk2(o[6], o[7]);
                    *(u32x4*)(ACT + (size_t)r * ldc + u.col0 + wc * 32 + 8 * fq) = w; }
            }
    }
};

struct SchedP1 {
    int G, c, l; unsigned char* ws;
    __device__ __forceinline__ bool next(int i, Unit& u) const {
        int L = i * G + c; if (L >= 1912) return false;
        const char* H = (const char*)(ws + WS_H); const char* MEMN = (const char*)(ws + WS_MEMN) + (size_t)l * 1024 * D * 2; const char* WMEM = (const char*)(ws + WS_WMEM) + (size_t)l * 1536 * D * 2;
        u.nt = 32; u.lim = 1 << 30; u.kind = K_PLAIN; u.lda2 = 4096; u.ldb2 = 4096;
        int pm, pn;
        if (L < 480) { g8::tile_map(L, 32, 15, pm, pn); u.A = H + (size_t)pm * 256 * 4096; u.B = (const char*)(ws + WS_WIN) + (size_t)l * ZC * D * 2 + (size_t)pn * 256 * 4096;
            u.O = (char*)(ws + WS_Z) + ((size_t)pm * 256 * ZC + pn * 256) * 2; u.ldc = ZC; u.row0 = pm * 256; u.col0 = pn * 256; if (pn >= 6 && pn < 12) u.kind = K_ZROT; return true; }
        L -= 480;
        if (L < 384) { g8::tile_map(L, 12, 32, pm, pn); u.A = (const char*)(ws + WS_WS) + (size_t)l * SWR * D * 2 + (size_t)pm * 256 * 4096; u.B = H + (size_t)pn * 256 * 4096; u.row0 = pm * 256; u.col0 = pn * 256;
            if (pm < 6) { u.O = (char*)(ws + WS_VT) + ((size_t)pm * 256 * T + pn * 256) * 2; u.ldc = T; }
            else { const int q = pm - 6, cs = q / 3, n0 = (q % 3) * 256, b = pn >> 3, s0 = (pn & 7) * 256; u.O = (char*)(ws + WS_UT) + (((size_t)(b * 768 + n0)) * 4096 + cs * 2048 + s0) * 2; u.ldc = 4096; }
            return true; }
        L -= 384;
        if (L < 1024) { g8::tile_map(L, 32, 32, pm, pn); u.A = H + (size_t)pm * 256 * 4096; u.B = (const char*)(ws + WS_WG) + (size_t)l * 8192 * D * 2 + (size_t)pn * 256 * 4096;
            u.O = (char*)(ws + WS_G) + ((size_t)pm * 256 * 8192 + pn * 256) * 2; u.ldc = 8192; u.row0 = pm * 256; u.col0 = pn * 256; u.kind = K_GATE; return true; }
        L -= 1024;
        if (L < 12) { pm = L % 4; pn = L / 4; u.A = MEMN + (size_t)pm * 256 * 4096; u.B = WMEM + (size_t)pn * 256 * 4096;
            u.O = (char*)(ws + WS_KM) + ((size_t)pm * 256 * 768 + pn * 256) * 2; u.ldc = 768; u.row0 = pm * 256; u.col0 = pn * 256; return true; }
        L -= 12;
        pm = L % 3; pn = L / 3; u.A = WMEM + (size_t)(768 + pm * 256) * 4096; u.B = MEMN + (size_t)pn * 256 * 4096;
        u.O = (char*)(ws + WS_VMT) + ((size_t)pm * 256 * 1024 + pn * 256) * 2; u.ldc = 1024; u.row0 = pm * 256; u.col0 = pn * 256; return true;
    }
};
struct SchedDFT {
    int c; unsigned char* ws;
    __device__ __forceinline__ bool next(int i, Unit& u) const {
        if (i > 0 || c >= 96) return false;
        const int b = c / 24, rem = c % 24, pm = rem & 7, pn = rem >> 3;
        u.A = (const char*)(ws + WS_DFT) + (size_t)pm * 256 * 8192; u.B = (const char*)(ws + WS_UT) + (size_t)(b * 768 + pn * 256) * 8192; u.lda2 = 8192; u.ldb2 = 8192; u.nt = 64; u.kind = K_PLAIN; u.lim = 1 << 30;
        u.row0 = b * 2048 + pm * 256; u.col0 = pn * 256; u.O = (char*)(ws + WS_YB) + ((size_t)u.row0 * 768 + u.col0) * 2; u.ldc = 768; return true;
    }
};
struct SchedP3 {
    int G, c, l; unsigned char* ws;
    __device__ __forceinline__ bool next(int i, Unit& u) const {
        const int ti = i >> 2, seg = i & 3; const int L = ti * G + c; if (L >= 256) return false;
        int pm, pn; g8::tile_map(L, 32, 8, pm, pn);
        const int kseg = (seg == 2) ? 256 : 768;
        const size_t ao = seg == 0 ? WS_YA : seg == 1 ? WS_YB : seg == 2 ? WS_YC : WS_YM;
        const size_t wo = seg == 0 ? 0 : seg == 1 ? 3 * MiB : seg == 2 ? 6 * MiB : 7 * MiB;
        u.A = (const char*)(ws + ao) + (size_t)pm * 256 * kseg * 2; u.B = (const char*)(ws + WS_WBR) + (size_t)l * 10 * MiB + wo + (size_t)pn * 256 * kseg * 2; u.lda2 = kseg * 2; u.ldb2 = kseg * 2; u.nt = kseg / 64; u.kind = seg;
        u.row0 = pm * 256; u.col0 = pn * 256; u.lim = 1 << 30; u.O = nullptr; u.ldc = 0; return true;
    }
};
struct SchedSimple {
    int G, c; const char *A, *B; unsigned lda2, ldb2; int nM, nN, nt, colmul;
    __device__ __forceinline__ bool next(int i, Unit& u) const {
        const int L = i * G + c; if (L >= nM * nN) return false;
        int pm, pn; g8::tile_map(L, nM, nN, pm, pn);
        u.A = A + (size_t)pm * 256 * lda2; u.B = B + (size_t)pn * 256 * ldb2; u.lda2 = lda2; u.ldb2 = ldb2; u.nt = nt; u.kind = 0; u.row0 = pm * 256; u.col0 = pn * colmul; u.lim = 1 << 30; u.O = nullptr; u.ldc = 0; return true;
    }
};
struct SchedMoe {
    int G, c; const char *A, *B; unsigned lda2, ldb2; size_t wstride; int nN, nt, colmul; const int* cntp;
    __device__ __forceinline__ bool next(int i, Unit& u) const {
        int L = i * G + c; int off = 0;
        for (int e = 0; e < 8; ++e) {
            const int ce = cntp[e]; const int rt = (ce + 255) >> 8, nu = rt * nN;
            if (L < nu) { int pm, pn; g8::tile_map(L, rt, nN, pm, pn);
                u.A = A + (size_t)(off + pm * 256) * lda2; u.B = B + (size_t)e * wstride + (size_t)pn * 256 * ldb2; u.lda2 = lda2; u.ldb2 = ldb2; u.nt = nt; u.kind = 0;
                u.row0 = off + pm * 256; u.col0 = pn * colmul; u.lim = off + ce; u.O = nullptr; u.ldc = 0; return true; }
            L -= nu; off += ce;
        }
        return false;
    }
};

struct UnitTab {
    const LAS u32x4* tab;
    __device__ __forceinline__ bool next(int i, Unit& u) const {
        if (i >= 32) return false;
        const u32x4 q0 = tab[i * 4 + 0], q1 = tab[i * 4 + 1], q2 = tab[i * 4 + 2], q3 = tab[i * 4 + 3];
#define RFL(x) ((unsigned)__builtin_amdgcn_readfirstlane((int)(x)))
        u.nt = (int)RFL(q2.y); if (u.nt == 0) return false;
        u.A = (const char*)(GAS const char*)(((unsigned long long)RFL(q0.y) << 32) | RFL(q0.x)); u.B = (const char*)(GAS const char*)(((unsigned long long)RFL(q0.w) << 32) | RFL(q0.z)); u.O = (char*)(GAS char*)(((unsigned long long)RFL(q1.y) << 32) | RFL(q1.x));
        u.lda2 = RFL(q1.z); u.ldb2 = RFL(q1.w); u.ldc = (int)RFL(q2.x); u.kind = (int)RFL(q2.z); u.row0 = (int)RFL(q2.w); u.col0 = (int)RFL(q3.x); u.lim = (int)RFL(q3.y);
#undef RFL
        return true;
    }
};
template <class Sched> __device__ __forceinline__ UnitTab build_units(LAS unsigned char* lds, const Sched& S) {
    LAS u32x4* tab = (LAS u32x4*)(lds + UTAB_OFF);
    __syncthreads();
    if (threadIdx.x < 32) { Unit u; const bool ok = S.next((int)threadIdx.x, u); const int t = threadIdx.x;
        const unsigned long long a = (unsigned long long)u.A, b = (unsigned long long)u.B, o = (unsigned long long)u.O;
        tab[t * 4 + 0] = (u32x4){(unsigned)a, (unsigned)(a >> 32), (unsigned)b, (unsigned)(b >> 32)};
        tab[t * 4 + 1] = (u32x4){(unsigned)o, (unsigned)(o >> 32), u.lda2, u.ldb2};
        tab[t * 4 + 2] = (u32x4){(unsigned)u.ldc, ok ? (unsigned)u.nt : 0u, (unsigned)u.kind, (unsigned)u.row0};
        tab[t * 4 + 3] = (u32x4){(unsigned)u.col0, (unsigned)u.lim, 0u, 0u}; }
    __syncthreads();
    UnitTab T_; T_.tab = tab; return T_;
}

struct Args { const float* in[23]; float* out; unsigned char* ws; int ph_lo, ph_hi; };
typedef const __attribute__((address_space(4))) Args* KArgsPtr;
__device__ __forceinline__ KArgsPtr kargs() { unsigned long long p = (unsigned long long)__builtin_amdgcn_kernarg_segment_ptr(); asm volatile("" : "+s"(p)); return (KArgsPtr)p; }
struct Frame {
    LAS unsigned char* lds; volatile LAS unsigned* MISC;
    int tid, lane, wave, G, bx;
};
__device__ __forceinline__ float wave_sum(float v) {
#pragma unroll
    for (int o = 1; o < 64; o <<= 1) v += __shfl_xor(v, o);
    return v;
}

__device__ __forceinline__ void tr_item(const float* W, int ldn, int K, int col0, int ncols, bf16_t* WT, int mode, LAS float* scr, int item, int lane) {
    const int nblk = ncols >> 5, kb = item / nblk, nb = item - kb * nblk, k0 = 64 * kb, n0 = 32 * nb;
    const float* src = W + (size_t)(k0 + (lane >> 5)) * ldn + col0 + n0 + (lane & 31);
    float v[32];
#pragma unroll
    for (int i = 0; i < 32; ++i) v[i] = src[(size_t)(2 * i) * ldn];
#pragma unroll
    for (int i = 0; i < 32; ++i) scr[(2 * i + (lane >> 5)) * 33 + (lane & 31)] = v[i];
    LDS_WAIT(); asm volatile("" ::: "memory");
    const int c = lane & 7;
#pragma unroll
    for (int j = 0; j < 4; ++j) { const int n = (lane >> 3) + 8 * j; const LAS float* s = scr + (8 * c) * 33 + n;
        u32x4 o; o.x = pk2(s[0 * 33], s[1 * 33]); o.y = pk2(s[2 * 33], s[3 * 33]); o.z = pk2(s[4 * 33], s[5 * 33]); o.w = pk2(s[6 * 33], s[7 * 33]);
        const int nn = n0 + n; const int drow = mode == 0 ? nn : ((nn >> 7) * 256 + (mode == 2 ? 128 : 0) + (nn & 127));
        *(u32x4*)(WT + (size_t)drow * K + k0 + 8 * c) = o; }
    LDS_WAIT(); asm volatile("" ::: "memory");
}
__device__ __forceinline__ void rms_row_bf16(const float* xrow, const float* gain, bf16_t* orow, int lane) {
    const f32x4* xr = (const f32x4*)xrow + lane; const f32x4* gr = (const f32x4*)gain + lane;
    f32x4 v[8]; float s = 0.f;
#pragma unroll
    for (int j = 0; j < 8; ++j) { v[j] = xr[64 * j]; s += (v[j].x * v[j].x + v[j].y * v[j].y) + (v[j].z * v[j].z + v[j].w * v[j].w); }
    const float rstd = __builtin_amdgcn_rsqf(wave_sum(s) * (1.f / D) + RMS_EPS);
    u32x2* o8 = (u32x2*)orow + lane;
#pragma unroll
    for (int j = 0; j < 8; ++j) { const f32x4 g = gr[64 * j]; u32x2 w; w.x = pk2(v[j].x * rstd * g.x, v[j].y * rstd * g.y); w.y = pk2(v[j].z * rstd * g.z, v[j].w * rstd * g.w); o8[64 * j] = w; }
}
__constant__ float ROPE_F[16] = {1.591549431e-01f, 7.008652159e-02f, 3.086376340e-02f, 1.359137064e-02f, 5.985185713e-03f, 2.635675899e-03f, 1.160663641e-03f, 5.111175045e-04f,
                                 2.250790790e-04f, 9.911730937e-05f, 4.364795279e-05f, 1.922110068e-05f, 8.464330808e-06f, 3.727408602e-06f, 1.641426263e-06f, 7.228293069e-07f};

__device__ __forceinline__ void p0_prologue(Frame& F) {
    LAS float* scr = (LAS float*)(F.lds + F.wave * 16384);
    LAS f32x2* trig = (LAS f32x2*)(F.lds + XTAB_OFF);
    if (F.tid < 128) { const float a = (float)F.tid * (1.f / 64.f); trig[F.tid] = (f32x2){cospif(a) * 0.08838834765f, sinpif(a) * 0.08838834765f}; }
    __syncthreads();
    const int gw = F.bx * NWAVES + F.wave, NGW = F.G * NWAVES, lane = F.lane;
    KArgsPtr ka = kargs(); unsigned char* ws = (unsigned char*)(GAS unsigned char*)ka->ws;
    for (int it = gw; it < 768; it += NGW) {
        const int l = it / 384, rem = it % 384, g = rem / 64, k0 = (rem % 64) * 32;
        const float* W = ((const float*)(GAS const float*)ka->in[3]) + (size_t)l * D * 6144 + 4608 + g * 128;
#pragma unroll 8
        for (int kk = 0; kk < 32; ++kk) { const f32x2 w = *(const f32x2*)(W + (size_t)(k0 + kk) * 6144 + 2 * lane); *(LAS f32x2*)(scr + kk * 128 + 2 * lane) = w; }
        LDS_WAIT(); asm volatile("" ::: "memory");
        bf16_t* dst = (bf16_t*)(ws + WS_WS) + (size_t)l * SWR * D + (size_t)(1536 + g * 128) * D;
        for (int kc = 0; kc < 4; ++kc) {
            float a[2][2][8];
#pragma unroll
            for (int p = 0; p < 2; ++p)
#pragma unroll
                for (int q = 0; q < 2; ++q)
#pragma unroll
                    for (int k = 0; k < 8; ++k) a[p][q][k] = 0.f;
            for (int c = 0; c < 128; ++c) {
                const f32x2 t0 = trig[(c * lane) & 127], t1 = trig[(c * (lane + 64)) & 127];
#pragma unroll
                for (int k = 0; k < 8; ++k) { const float w = scr[(kc * 8 + k) * 128 + c]; a[0][0][k] += w * t0.x; a[0][1][k] += w * t0.y; a[1][0][k] += w * t1.x; a[1][1][k] += w * t1.y; }
            }
#pragma unroll
            for (int p = 0; p < 2; ++p)
#pragma unroll
                for (int q = 0; q < 2; ++q) { u32x4 o; o.x = pk2(a[p][q][0], a[p][q][1]); o.y = pk2(a[p][q][2], a[p][q][3]); o.z = pk2(a[p][q][4], a[p][q][5]); o.w = pk2(a[p][q][6], a[p][q][7]);
                    *(u32x4*)(dst + (size_t)(q * 768 + lane + 64 * p) * D + k0 + kc * 8) = o; }
        }
        LDS_WAIT(); asm volatile("" ::: "memory");
    }
    for (int it = gw; it < 2048; it += NGW) {
        bf16_t* row = (bf16_t*)(ws + WS_DFT) + (size_t)it * 4096;
#pragma unroll 2
        for (int j = 0; j < 8; ++j) { const int c0 = 8 * (lane + 64 * j); float v[8];
#pragma unroll
            for (int e = 0; e < 8; ++e) { const int cc = c0 + e, k = cc & 2047; const float a = (float)((it * k) & 2047) * (1.f / 1024.f); v[e] = (cc < 2048 ? cospif(a) : -sinpif(a)) * 0.02209708691f; }
            u32x4 o; o.x = pk2(v[0], v[1]); o.y = pk2(v[2], v[3]); o.z = pk2(v[4], v[5]); o.w = pk2(v[6], v[7]); *(u32x4*)(row + c0) = o; }
    }
    for (int it = gw; it < 512; it += NGW) {
        const int pos = it * 4 + (lane >> 4), i = lane & 15; const float f = ROPE_F[i], p = (float)pos;
        const float hi = p * f, lo = fmaf(p, f, -hi); const float fr = (hi - floorf(hi)) + lo;
        ((f32x2*)(ws + WS_TAB))[pos * 16 + i] = (f32x2){cospif(2.f * fr), sinpif(2.f * fr)};
    }
    for (int it = gw; it < T + 2 * 1024; it += NGW) {
        if (it < T) rms_row_bf16(((const float*)(GAS const float*)ka->in[0]) + (size_t)it * D, ((const float*)(GAS const float*)ka->in[2]), (bf16_t*)(ws + WS_H) + (size_t)it * D, lane);
        else { const int l = (it - T) >> 10, r = (it - T) & 1023; rms_row_bf16(((const float*)(GAS const float*)ka->in[1]) + (size_t)r * D, ((const float*)(GAS const float*)ka->in[5]) + l * D, (bf16_t*)(ws + WS_MEMN) + ((size_t)l * 1024 + r) * D, lane); }
    }
    constexpr int I_E = (D / 64) * (EFF / 32), I_ED = (EFF / 64) * (D / 32);
    constexpr int I_EXP = 8 * (2 * I_E + I_ED);
    constexpr int I_DG = (D / 64) * (DFF / 32), I_DDN = (DFF / 64) * (D / 32);
    constexpr int I_IN1 = 32 * (1536 / 32), I_IN2 = 32 * (768 / 32), I_MEM = 32 * (1536 / 32), I_BR = 12 * 64, I_BRC = 4 * 64, I_GT = 32 * 256, I_WO = 32 * 64;
    constexpr int I_LAYER = I_IN1 + I_IN2 + I_IN1 + I_IN2 + I_IN2 + I_MEM + 3 * I_BR + I_BRC + I_GT + I_WO;
    constexpr int NITEMS = I_EXP + 2 * I_DG + I_DDN + 2 * I_LAYER;
    for (int it = gw; it < NITEMS; it += NGW) {
        KArgsPtr kb = kargs(); unsigned char* wsb = (unsigned char*)(GAS unsigned char*)kb->ws;
        int r = it; const float* src = nullptr; bf16_t* dst = nullptr; int ldn = 0, K = 0, col0 = 0, ncols = 32, mode = 0; bool done = false;
#define TJ(n_, src_, ldn_, K_, col0_, ncols_, dst_, mode_) if (!done) { if (r < (n_)) { src = (src_); ldn = (ldn_); K = (K_); col0 = (col0_); ncols = (ncols_); dst = (dst_); mode = (mode_); done = true; } else r -= (n_); }
        if (r < I_EXP) { const int e = r / (2 * I_E + I_ED); r -= e * (2 * I_E + I_ED);
            TJ(I_E, ((const float*)(GAS const float*)kb->in[19]) + (size_t)e * D * EFF, EFF, D, 0, EFF, (bf16_t*)(wsb + WS_EGU) + (size_t)e * 14336 * D, 1)
            TJ(I_E, ((const float*)(GAS const float*)kb->in[20]) + (size_t)e * D * EFF, EFF, D, 0, EFF, (bf16_t*)(wsb + WS_EGU) + (size_t)e * 14336 * D, 2)
            TJ(I_ED, ((const float*)(GAS const float*)kb->in[21]) + (size_t)e * EFF * D, D, EFF, 0, D, (bf16_t*)(wsb + WS_ED) + (size_t)e * D * EFF, 0)
        } else { r -= I_EXP;
            TJ(I_DG, ((const float*)(GAS const float*)kb->in[15]), DFF, D, 0, DFF, (bf16_t*)(wsb + WS_DGU), 1)
            TJ(I_DG, ((const float*)(GAS const float*)kb->in[16]), DFF, D, 0, DFF, (bf16_t*)(wsb + WS_DGU), 2)
            TJ(I_DDN, ((const float*)(GAS const float*)kb->in[17]), D, DFF, 0, D, (bf16_t*)(wsb + WS_DD), 0)
            if (!done) { const int l = r / I_LAYER; r -= l * I_LAYER;
                bf16_t* WINl = (bf16_t*)(wsb + WS_WIN) + (size_t)l * ZC * D; bf16_t* WSl = (bf16_t*)(wsb + WS_WS) + (size_t)l * SWR * D; unsigned char* wbr = wsb + WS_WBR + (size_t)l * 10 * MiB;
                TJ(I_IN1, ((const float*)(GAS const float*)kb->in[3]) + (size_t)l * D * 6144, 6144, D, 0, 1536, WINl, 0)
                TJ(I_IN2, ((const float*)(GAS const float*)kb->in[3]) + (size_t)l * D * 6144, 6144, D, 1536, 768, WSl, 0)
                TJ(I_IN1, ((const float*)(GAS const float*)kb->in[3]) + (size_t)l * D * 6144, 6144, D, 2304, 1536, WINl + (size_t)1536 * D, 0)
                TJ(I_IN2, ((const float*)(GAS const float*)kb->in[3]) + (size_t)l * D * 6144, 6144, D, 3840, 768, WSl + (size_t)768 * D, 0)
                TJ(I_IN2, ((const float*)(GAS const float*)kb->in[3]) + (size_t)l * D * 6144, 6144, D, 5376, 768, WINl + (size_t)3072 * D, 0)
                TJ(I_MEM, ((const float*)(GAS const float*)kb->in[6]) + (size_t)l * D * 1536, 1536, D, 0, 1536, (bf16_t*)(wsb + WS_WMEM) + (size_t)l * 1536 * D, 0)
                TJ(I_BR, ((const float*)(GAS const float*)kb->in[7]) + (size_t)l * 768 * D, D, 768, 0, D, (bf16_t*)(wbr), 0)
                TJ(I_BR, ((const float*)(GAS const float*)kb->in[8]) + (size_t)l * 768 * D, D, 768, 0, D, (bf16_t*)(wbr + 3 * MiB), 0)
                TJ(I_BRC, ((const float*)(GAS const float*)kb->in[9]) + (size_t)l * 256 * D, D, 256, 0, D, (bf16_t*)(wbr + 6 * MiB), 0)
                TJ(I_BR, ((const float*)(GAS const float*)kb->in[10]) + (size_t)l * 768 * D, D, 768, 0, D, (bf16_t*)(wbr + 7 * MiB), 0)
                TJ(I_GT, ((const float*)(GAS const float*)kb->in[11]) + (size_t)l * D * 8192, 8192, D, 0, 8192, (bf16_t*)(wsb + WS_WG) + (size_t)l * 8192 * D, 0)
                TJ(I_WO, ((const float*)(GAS const float*)kb->in[13]) + (size_t)l * D * D, D, D, 0, D, (bf16_t*)(wsb + WS_WO) + (size_t)l * D * D, 0)
            }
        }
#undef TJ
        tr_item(src, ldn, K, col0, ncols, dst, mode, scr, r, lane);
    }
}

#define MFMA32(a, b, c) __builtin_amdgcn_mfma_f32_32x32x16_bf16((a), (b), (c), 0, 0, 0)
template <int HD> struct AttnSt { f32x16 o[HD / 32]; float m, l; };
template <int HD> __device__ __forceinline__ void attn_init(AttnSt<HD>& st) {
#pragma unroll
    for (int b = 0; b < HD / 32; ++b)
#pragma unroll
        for (int i = 0; i < 16; ++i) st.o[b][i] = 0.f;
    st.m = -1e30f; st.l = 0.f;
}
template <int HD, bool QREG, class MaskF>
__device__ __forceinline__ void attn_tile(AttnSt<HD>& st, const bf16x8 (&qf)[HD / 16], const bf16_t* qp, const bf16_t* kp, const bf16_t* vp, size_t ldv, float sc, const MaskF& mf) {
    f32x16 x;
#pragma unroll
    for (int i = 0; i < 16; ++i) x[i] = 0.f;
#pragma unroll
    for (int kk = 0; kk < HD / 16; ++kk) { const bf16x8 a = *(const bf16x8*)(kp + 16 * kk); const bf16x8 b = QREG ? qf[kk] : *(const bf16x8*)(qp + 16 * kk); x = MFMA32(a, b, x); }
    float s[16]; bool ok[16]; float mt = -1e30f;
#pragma unroll
    for (int i = 0; i < 16; ++i) { float bias; ok[i] = mf(i, bias); s[i] = x[i] * sc + bias; mt = fmaxf(mt, ok[i] ? s[i] : -1e30f); }
    mt = fmaxf(mt, __shfl_xor(mt, 32));
    const float mn = fmaxf(st.m, mt), alpha = __builtin_amdgcn_exp2f(st.m - mn);
    float ps = 0.f; float p[16];
#pragma unroll
    for (int i = 0; i < 16; ++i) { p[i] = ok[i] ? __builtin_amdgcn_exp2f(s[i] - mn) : 0.f; ps += p[i]; }
    st.l = st.l * alpha + ps; st.m = mn;
    bf16x8 xs[2];
#pragma unroll
    for (int h2 = 0; h2 < 2; ++h2) { u32x4 w; w.x = pk2(p[8 * h2 + 0], p[8 * h2 + 1]); w.y = pk2(p[8 * h2 + 2], p[8 * h2 + 3]); w.z = pk2(p[8 * h2 + 4], p[8 * h2 + 5]); w.w = pk2(p[8 * h2 + 6], p[8 * h2 + 7]); xs[h2] = __builtin_bit_cast(bf16x8, w); }
#pragma unroll
    for (int b = 0; b < HD / 32; ++b) {
#pragma unroll
        for (int i = 0; i < 16; ++i) st.o[b][i] *= alpha;
#pragma unroll
        for (int h2 = 0; h2 < 2; ++h2) {
            const bf16_t* v = vp + (size_t)(32 * b) * ldv + 16 * h2;
            const u32x2 lo = *(const u32x2*)v, hi = *(const u32x2*)(v + 8);
            u32x4 w; w.x = lo.x; w.y = lo.y; w.z = hi.x; w.w = hi.y;
            st.o[b] = MFMA32(__builtin_bit_cast(bf16x8, w), xs[h2], st.o[b]);
        }
    }
}
template <int HD> __device__ __forceinline__ void attn_store(const AttnSt<HD>& st, bf16_t* yq  ) {
    const float lt = st.l + __shfl_xor(st.l, 32); const float inv = 1.f / lt;
#pragma unroll
    for (int b = 0; b < HD / 32; ++b)
#pragma unroll
        for (int g = 0; g < 4; ++g) { u32x2 w; w.x = pk2(st.o[b][4 * g] * inv, st.o[b][4 * g + 1] * inv); w.y = pk2(st.o[b][4 * g + 2] * inv, st.o[b][4 * g + 3] * inv); *(u32x2*)(yq + 32 * b + 8 * g) = w; }
}

struct MaskNone { __device__ __forceinline__ bool operator()(int, float& b) const { b = 0.f; return true; } };
struct MaskNA { int h4, cq, c0, jk0; const LAS float* rp;
    __device__ __forceinline__ bool operator()(int i, float& b) const { const int jk = jk0 + (i & 3) + 8 * (i >> 2) + h4; const bool ok = (jk >= c0) && (jk < c0 + 16); const int dc = ok ? (jk - cq + 15) : 0; b = rp[dc]; return ok; } };
struct MaskDil { int h4, q, k0, dg;
    __device__ __forceinline__ bool operator()(int i, float& b) const { const int k = k0 + (i & 3) + 8 * (i >> 2) + h4; const int d = k - q; b = 0.f; return (d <= 64 * dg) && (d >= -64 * dg) && ((d & (dg - 1)) == 0); } };

__device__ __forceinline__ void attn_phase(Frame& F, unsigned char* ws, int l) {
    const int lane = F.lane, r = lane & 31, h = lane >> 5;
    const bf16_t* Z = (const bf16_t*)(ws + WS_Z); const bf16_t* VT = (const bf16_t*)(ws + WS_VT);
    const LAS float* rpb = (const LAS float*)(F.lds + XTAB_OFF);
    unsigned* qhead = (unsigned*)(ws + WS_CTL) + CW_Q + 64 * l;
    for (;;) {
        int j = 0; if (lane == 0) j = (int)__hip_atomic_fetch_add(qhead, 1u, __ATOMIC_RELAXED, __HIP_MEMORY_SCOPE_AGENT);
        j = __builtin_amdgcn_readfirstlane(j);
        if (j >= 3072) break;
        if (j < 512) {
            const int b = j >> 7, hh = (j >> 6) & 1, q0 = (j & 63) * 32; const int q = q0 + r;
            AttnSt<128> st; attn_init(st);
            for (int g = 0; g < 3; ++g) {
                const int dg = g == 0 ? 1 : g == 1 ? 4 : 16, hd = g * 2 + hh;
                const bf16_t* qp = Z + (size_t)(b * SEQ + q) * ZC + 1536 + hd * 128 + 8 * h;
                bf16x8 qf[8];
#pragma unroll
                for (int kk = 0; kk < 8; ++kk) qf[kk] = *(const bf16x8*)(qp + 16 * kk);
                int klo = q0 - 64 * dg; if (klo < 0) klo = 0; int khi = q0 + 32 + 64 * dg; if (khi > SEQ) khi = SEQ;
                const bf16_t* kbase = Z + (size_t)(b * SEQ + r) * ZC + 2304 + hd * 128 + 8 * h;
                const bf16_t* vbase = VT + (size_t)(768 + hd * 128 + r) * T + b * SEQ + 4 * h;
                for (int k0 = klo; k0 < khi; k0 += 32) {
                    MaskDil mf{4 * h, q, k0, dg};
                    attn_tile<128, true>(st, qf, qp, kbase + (size_t)k0 * ZC, vbase + k0, (size_t)T, 0.08838834765f * 1.44269504f, mf);
                }
            }
            attn_store<128>(st, (bf16_t*)(ws + WS_YC) + (size_t)(b * SEQ + q) * 256 + hh * 128 + 4 * h);
        } else if (j < 2048) {
            const int jj = j - 512; const int half = jj & 1, gr = (jj >> 1) & 31, hd = (jj >> 6) % 6, b = jj / 384;
            const int cq = 32 * half + r; int c0 = cq - 8; c0 = c0 < 0 ? 0 : (c0 > 48 ? 48 : c0);
            int r0 = gr - 4; r0 = r0 < 0 ? 0 : (r0 > 24 ? 24 : r0);
            const int tq = b * SEQ + gr * 64 + cq;
            const bf16_t* qp = Z + (size_t)tq * ZC + hd * 128 + 8 * h;
            bf16x8 qf[8];
#pragma unroll
            for (int kk = 0; kk < 8; ++kk) qf[kk] = *(const bf16x8*)(qp + 16 * kk);
            AttnSt<128> st; attn_init(st);
            for (int kr = 0; kr < 8; ++kr) {
                const LAS float* rp = rpb + (hd * 15 + (r0 + kr - gr + 7)) * 31;
#pragma unroll 1
                for (int ch = 0; ch < 2; ++ch) {
                    const int tk0 = b * SEQ + (r0 + kr) * 64 + 32 * ch;
                    MaskNA mf{4 * h, cq, c0, 32 * ch, rp};
                    attn_tile<128, true>(st, qf, qp, Z + (size_t)(tk0 + r) * ZC + 768 + hd * 128 + 8 * h, VT + (size_t)(hd * 128 + r) * T + tk0 + 4 * h, (size_t)T, 0.08838834765f * 1.44269504f, mf);
                }
            }
            attn_store<128>(st, (bf16_t*)(ws + WS_YA) + (size_t)tq * 768 + hd * 128 + 4 * h);
        } else {
            const int jj = j - 2048; const int qb = jj & 63, hd = (jj >> 6) & 3, b = jj >> 8;
            const int tq = b * SEQ + qb * 32 + r;
            const bf16_t* qp = Z + (size_t)tq * ZC + 3072 + hd * 192 + 8 * h;
            bf16x8 qf[12];
            AttnSt<192> st; attn_init(st);
            const bf16_t* kbase = (const bf16_t*)(ws + WS_KM) + (size_t)(b * MEML + r) * 768 + hd * 192 + 8 * h;
            const bf16_t* vbase = (const bf16_t*)(ws + WS_VMT) + (size_t)(hd * 192 + r) * 1024 + b * MEML + 4 * h;
            for (int k0 = 0; k0 < MEML; k0 += 32) {
                MaskNone mf;
                attn_tile<192, false>(st, qf, qp, kbase + (size_t)k0 * 768, vbase + k0, (size_t)1024, 0.07216878365f * 1.44269504f, mf);
            }
            attn_store<192>(st, (bf16_t*)(ws + WS_YM) + (size_t)tq * 768 + hd * 192 + 4 * h);
        }
    }
}

constexpr int NPHASE = 19;

#ifndef PHASE_MASK
#define PHASE_MASK 0x7ffff
#endif
#define GRID_BAR() do { if (N_LAUNCHES == 1) xcd_barrier(bar); } while (0)
#define IN(k) ((((PHASE_MASK) >> ((k) % 32)) & 1) && lo <= (k) && (k) < hi)
#define BOTH(k) (IN(k) && IN((k) + 1))
#define PHASE_ENV() KArgsPtr ka = kargs(); unsigned char* ws = (unsigned char*)(GAS unsigned char*)ka->ws; const int gw = F.bx * NWAVES + F.wave, NGW = F.G * NWAVES, lane = F.lane; (void)gw; (void)NGW; (void)lane
template <int l> __device__ __forceinline__ void mixer_phases(Frame& F, const XcdBarrier& bar, const int lo, const int hi) {
        const int pb = 1 + 8 * l;
        if (IN(pb)) {
            PHASE_ENV();
            SchedP1 S; S.G = F.G; S.c = F.bx; S.l = l; S.ws = ws;
            EpiP1 E; E.bgate = ((const float*)(GAS const float*)ka->in[12]) + (size_t)l * 8192; E.rope = (const f32x2*)(ws + WS_TAB);
            { const UnitTab UT_ = build_units(F.lds, S); g8::gemm_phase<EpiP1, UnitTab>(F.lds, UT_, E); }
            if (BOTH(pb)) GRID_BAR();
        }
        if (IN(pb + 1)) {
            PHASE_ENV();
            { LAS float* rpb = (LAS float*)(F.lds + XTAB_OFF); const float* src = ((const float*)(GAS const float*)ka->in[4]) + (size_t)l * 2790; for (int i = F.tid; i < 2790; i += NTHREADS) rpb[i] = src[i] * 1.44269504f; }
            __syncthreads();
            { SchedDFT S; S.c = F.bx; S.ws = ws;
              EpiPlain E;
              { const UnitTab UT_ = build_units(F.lds, S); g8::gemm_phase<EpiPlain, UnitTab>(F.lds, UT_, E); } }
            attn_phase(F, ws, l);
            if (BOTH(pb + 1)) GRID_BAR();
        }
        if (IN(pb + 2)) {
            PHASE_ENV();
            SchedP3 S; S.G = F.G; S.c = F.bx; S.l = l; S.ws = ws;
            EpiBranch E; E.G = (const bf16_t*)(ws + WS_G); E.MP = (float*)(ws + WS_MP); E.MG = (bf16_t*)(ws + WS_MG);
            { const UnitTab UT_ = build_units(F.lds, S); g8::gemm_phase<EpiBranch, UnitTab>(F.lds, UT_, E); }
            if (BOTH(pb + 2)) GRID_BAR();
        }
        if (IN(pb + 3)) {
            PHASE_ENV();
            SchedSimple S; S.G = F.G; S.c = F.bx; S.A = (const char*)(ws + WS_MG); S.B = (const char*)(ws + WS_WO) + (size_t)l * D * D * 2; S.lda2 = 4096; S.ldb2 = 4096; S.nM = 32; S.nN = 8; S.nt = 32; S.colmul = 256;
            EpiResid E; E.Xin = (l == 0) ? ((const float*)(GAS const float*)ka->in[0]) : (const float*)(ws + WS_X); E.Xout = (float*)(ws + WS_X); E.ldc = D;
            { const UnitTab UT_ = build_units(F.lds, S); g8::gemm_phase<EpiResid, UnitTab>(F.lds, UT_, E); }
            if (BOTH(pb + 3)) GRID_BAR();
        }
}
__device__ __forceinline__ void dense_ffn_phases(Frame& F, const XcdBarrier& bar, const int lo, const int hi) {
            if (IN(5)) { PHASE_ENV(); const float* gain = ((const float*)(GAS const float*)ka->in[14]); for (int it = gw; it < T; it += NGW) rms_row_bf16((const float*)(ws + WS_X) + (size_t)it * D, gain, (bf16_t*)(ws + WS_H) + (size_t)it * D, lane); if (BOTH(5)) GRID_BAR(); }
            if (IN(6)) {
                PHASE_ENV();
                SchedSimple S; S.G = F.G; S.c = F.bx; S.A = (const char*)(ws + WS_H); S.B = (const char*)(ws + WS_DGU); S.lda2 = 4096; S.ldb2 = 4096; S.nM = 32; S.nN = 44; S.nt = 32; S.colmul = 128;
                EpiSwiglu E; E.ACT = (bf16_t*)(ws + WS_ACT); E.ldc = DFF;
                { const UnitTab UT_ = build_units(F.lds, S); g8::gemm_phase<EpiSwiglu, UnitTab>(F.lds, UT_, E); }
                if (BOTH(6)) GRID_BAR();
            }
            if (IN(7)) {
                PHASE_ENV();
                SchedSimple S; S.G = F.G; S.c = F.bx; S.A = (const char*)(ws + WS_ACT); S.B = (const char*)(ws + WS_DD); S.lda2 = DFF * 2; S.ldb2 = DFF * 2; S.nM = 32; S.nN = 8; S.nt = DFF / 64; S.colmul = 256;
                EpiResid E; E.Xin = (const float*)(ws + WS_X); E.Xout = (float*)(ws + WS_X); E.ldc = D;
                { const UnitTab UT_ = build_units(F.lds, S); g8::gemm_phase<EpiResid, UnitTab>(F.lds, UT_, E); }
                if (BOTH(7)) GRID_BAR();
            }
            if (IN(8)) { PHASE_ENV(); const float* gain = ((const float*)(GAS const float*)ka->in[2]) + D; for (int it = gw; it < T; it += NGW) rms_row_bf16((const float*)(ws + WS_X) + (size_t)it * D, gain, (bf16_t*)(ws + WS_H) + (size_t)it * D, lane); if (BOTH(8)) GRID_BAR(); }
}
__device__ __forceinline__ void moe_ffn_phases(Frame& F, const XcdBarrier& bar, const int lo, const int hi) {
            if (IN(13)) {
                PHASE_ENV();
                const float* rt = ((const float*)(GAS const float*)ka->in[18]); const float* gain = ((const float*)(GAS const float*)ka->in[14]) + D;
                for (int it = gw; it < T; it += NGW) {
                    const f32x4* xr = (const f32x4*)((const float*)(ws + WS_X) + (size_t)it * D) + lane; const f32x4* gr = (const f32x4*)gain + lane;
                    f32x4 v[8]; float s = 0.f;
#pragma unroll
                    for (int j = 0; j < 8; ++j) { v[j] = xr[64 * j]; s += (v[j].x * v[j].x + v[j].y * v[j].y) + (v[j].z * v[j].z + v[j].w * v[j].w); }
                    const float rstd = __builtin_amdgcn_rsqf(wave_sum(s) * (1.f / D) + RMS_EPS);
                    float lg[8];
#pragma unroll
                    for (int e = 0; e < 8; ++e) lg[e] = 0.f;
                    u32x2* o8 = (u32x2*)((bf16_t*)(ws + WS_H) + (size_t)it * D) + lane;
#pragma unroll
                    for (int j = 0; j < 8; ++j) { const f32x4 g = gr[64 * j]; v[j].x *= rstd * g.x; v[j].y *= rstd * g.y; v[j].z *= rstd * g.z; v[j].w *= rstd * g.w;
                        u32x2 w; w.x = pk2(v[j].x, v[j].y); w.y = pk2(v[j].z, v[j].w); o8[64 * j] = w; }
#pragma unroll
                    for (int j = 0; j < 8; ++j) { const f32x4 hv = v[j];
                        const f32x4* rr = (const f32x4*)(rt + (size_t)(4 * (lane + 64 * j)) * 8);
                        asm volatile("" ::: "memory");
#pragma unroll
                        for (int q = 0; q < 4; ++q) { const f32x4 r0 = rr[2 * q], r1 = rr[2 * q + 1]; const float hq = hv[q];
                            lg[0] += hq * r0.x; lg[1] += hq * r0.y; lg[2] += hq * r0.z; lg[3] += hq * r0.w; lg[4] += hq * r1.x; lg[5] += hq * r1.y; lg[6] += hq * r1.z; lg[7] += hq * r1.w; } }
#pragma unroll
                    for (int e = 0; e < 8; ++e) lg[e] = wave_sum(lg[e]);
                    if (lane == 0) {
                        int e1 = 0; float v1 = lg[0];
#pragma unroll
                        for (int e = 1; e < 8; ++e) if (lg[e] > v1) { v1 = lg[e]; e1 = e; }
                        int e2 = -1; float v2 = -3.0e38f;
#pragma unroll
                        for (int e = 0; e < 8; ++e) if (e != e1 && lg[e] > v2) { v2 = lg[e]; e2 = e; }
                        const float p2 = __expf(v2 - v1), w1 = 1.f / (1.f + p2), w2 = p2 / (1.f + p2);
                        ((int*)(ws + WS_TOKE))[2 * it] = e1; ((int*)(ws + WS_TOKE))[2 * it + 1] = e2;
                        ((float*)(ws + WS_TOKW))[2 * it] = w1; ((float*)(ws + WS_TOKW))[2 * it + 1] = w2;
                    }
                }
                if (BOTH(13)) GRID_BAR();
            }
            if (IN(14)) {
                PHASE_ENV();
                if (F.bx < 8) {
                    const int e = F.bx; const int* te = (const int*)(ws + WS_TOKE); int* rk = (int*)(ws + WS_RANK);
                    LAS int* wsum = (LAS int*)(F.lds);
                    int base = 0;
                    for (int c0 = 0; c0 < 2 * T; c0 += NTHREADS) {
                        const int idx = c0 + F.tid; const bool hit = te[idx] == e;
                        const unsigned long long bal = __ballot(hit);
                        const int pre = __popcll(bal & ((1ull << lane) - 1ull)), tot = __popcll(bal);
                        __syncthreads();
                        if (lane == 0) wsum[F.wave] = tot;
                        __syncthreads();
                        int woff = 0, all = 0;
#pragma unroll
                        for (int w = 0; w < 8; ++w) { const int t = wsum[w]; if (w < F.wave) woff += t; all += t; }
                        if (hit) rk[idx] = base + woff + pre;
                        base += all;
                    }
                    if (F.tid == 0) ((int*)(ws + WS_CTL))[CW_MOE + e] = base;
                }
                if (BOTH(14)) GRID_BAR();
            }
            if (IN(15)) {
                PHASE_ENV();
                int off[8]; { int a = 0;
#pragma unroll
                    for (int e = 0; e < 8; ++e) { off[e] = a; a += ((const int*)(ws + WS_CTL))[CW_MOE + e]; } }
                for (int it = gw; it < 2 * T; it += NGW) {
                    const int e = ((const int*)(ws + WS_TOKE))[it], rk = ((const int*)(ws + WS_RANK))[it];
                    int o = 0;
#pragma unroll
                    for (int q = 0; q < 8; ++q) o = (e == q) ? off[q] : o;
                    const int slot = o + rk;
                    if (lane == 0) ((int*)(ws + WS_TOKS))[it] = slot;
                    const u32x4* src = (const u32x4*)((const bf16_t*)(ws + WS_H) + (size_t)(it >> 1) * D) + lane; u32x4* dst = (u32x4*)((bf16_t*)(ws + WS_HA) + (size_t)slot * D) + lane;
#pragma unroll
                    for (int j = 0; j < 4; ++j) dst[64 * j] = src[64 * j];
                }
                if (BOTH(15)) GRID_BAR();
            }
            if (IN(16)) {
                PHASE_ENV();
                SchedMoe S; S.G = F.G; S.c = F.bx; S.A = (const char*)(ws + WS_HA); S.B = (const char*)(ws + WS_EGU); S.lda2 = 4096; S.ldb2 = 4096; S.wstride = (size_t)14336 * D * 2; S.nN = 56; S.nt = 32; S.colmul = 128;
                S.cntp = (const int*)(ws + WS_CTL) + CW_MOE;
                EpiSwiglu E; E.ACT = (bf16_t*)(ws + WS_EACT); E.ldc = EFF;
                { const UnitTab UT_ = build_units(F.lds, S); g8::gemm_phase<EpiSwiglu, UnitTab>(F.lds, UT_, E); }
                if (BOTH(16)) GRID_BAR();
            }
            if (IN(17)) {
                PHASE_ENV();
                SchedMoe S; S.G = F.G; S.c = F.bx; S.A = (const char*)(ws + WS_EACT); S.B = (const char*)(ws + WS_ED); S.lda2 = EFF * 2; S.ldb2 = EFF * 2; S.wstride = (size_t)D * EFF * 2; S.nN = 8; S.nt = EFF / 64; S.colmul = 256;
                S.cntp = (const int*)(ws + WS_CTL) + CW_MOE;
                EpiResid E; E.Xin = nullptr; E.Xout = (float*)(ws + WS_OS); E.ldc = D;
                { const UnitTab UT_ = build_units(F.lds, S); g8::gemm_phase<EpiResid, UnitTab>(F.lds, UT_, E); }
                if (BOTH(17)) GRID_BAR();
            }
            if (IN(18)) {
                PHASE_ENV();
                const float* fgain = ((const float*)(GAS const float*)ka->in[22]); float* outp = (float*)(GAS float*)ka->out;
                for (int it = gw; it < T; it += NGW) {
                    const int s1 = ((const int*)(ws + WS_TOKS))[2 * it], s2 = ((const int*)(ws + WS_TOKS))[2 * it + 1];
                    const float w1 = ((const float*)(ws + WS_TOKW))[2 * it], w2 = ((const float*)(ws + WS_TOKW))[2 * it + 1];
                    const f32x4* xr = (const f32x4*)((const float*)(ws + WS_X) + (size_t)it * D) + lane;
                    const f32x4* o1 = (const f32x4*)((const float*)(ws + WS_OS) + (size_t)s1 * D) + lane; const f32x4* o2 = (const f32x4*)((const float*)(ws + WS_OS) + (size_t)s2 * D) + lane;
                    const f32x4* gr = (const f32x4*)fgain + lane;
                    f32x4 v[8]; float s = 0.f;
#pragma unroll
                    for (int j = 0; j < 8; ++j) { v[j] = xr[64 * j] + w1 * o1[64 * j] + w2 * o2[64 * j]; s += (v[j].x * v[j].x + v[j].y * v[j].y) + (v[j].z * v[j].z + v[j].w * v[j].w); }
                    const float rstd = __builtin_amdgcn_rsqf(wave_sum(s) * (1.f / D) + RMS_EPS);
                    f32x4* orow = (f32x4*)(outp + (size_t)it * D) + lane;
#pragma unroll
                    for (int j = 0; j < 8; ++j) { const f32x4 g = gr[64 * j]; orow[64 * j] = v[j] * rstd * g; }
                }
            }
}
__global__ void __launch_bounds__(NTHREADS, 2) fwd_kernel(Args args) {
    extern __shared__ __attribute__((aligned(16))) unsigned char lds_raw[];
    Frame F;
    F.lds = (LAS unsigned char*)lds_raw; F.MISC = (volatile LAS unsigned*)(F.lds + MISC_OFF);
    F.tid = threadIdx.x; F.lane = F.tid & 63; F.wave = __builtin_amdgcn_readfirstlane(F.tid >> 6); F.G = gridDim.x; F.bx = blockIdx.x;
    if (F.tid < 64) ((LAS unsigned*)(F.lds + MISC_OFF))[F.tid] = 0u;
    __syncthreads();
    XcdBarrier bar; bar.bar = (unsigned*)(GAS unsigned*)(args.ws + WS_CTL) + CW_BAR; bar.x = 0; bar.st = nullptr;
    if (N_LAUNCHES == 1) bar = xcd_barrier_post((unsigned*)(GAS unsigned*)(args.ws + WS_CTL) + CW_BAR, F.MISC + 8);
    const int lo = args.ph_lo, hi = args.ph_hi;

    if (IN(0)) { p0_prologue(F); if (BOTH(0)) GRID_BAR(); }

    mixer_phases<0>(F, bar, lo, hi);
    dense_ffn_phases(F, bar, lo, hi);
    mixer_phases<1>(F, bar, lo, hi);
    moe_ffn_phases(F, bar, lo, hi);
}
#undef IN
#undef BOTH
#undef GRID_BAR
#undef PHASE_ENV

extern "C" void kernel_launch(void* const* d_in, const int* in_sizes, int n_in, void* d_out, int out_size, void* d_ws, size_t ws_size, hipStream_t stream) {
    static int grid = 0;
    if (grid == 0) {
        if (n_in != 23 || out_size != T * D || ws_size < WS_END) { fprintf(stderr, "kernel_launch: unexpected shapes (n_in %d out %d ws %zu need %zu)\n", n_in, out_size, ws_size, (size_t)WS_END); grid = -1; return; }
        int dev = 0, cus = 0, per_cu = 0;
        if (hipGetDevice(&dev) != hipSuccess || hipDeviceGetAttribute(&cus, hipDeviceAttributeMultiprocessorCount, dev) != hipSuccess) { grid = -1; return; }
        if (hipFuncSetAttribute((const void*)fwd_kernel, hipFuncAttributeMaxDynamicSharedMemorySize, LDS_BYTES) != hipSuccess) { fprintf(stderr, "kernel_launch: hipFuncSetAttribute failed\n"); grid = -1; return; }
        if (hipOccupancyMaxActiveBlocksPerMultiprocessor(&per_cu, (const void*)fwd_kernel, NTHREADS, LDS_BYTES) != hipSuccess || per_cu < 1) { fprintf(stderr, "kernel_launch: occupancy query says %d\n", per_cu); (void)hipGetLastError(); grid = -1; return; }
        grid = cus;
    }
    if (grid < 0) return;
    if (hipMemsetAsync((char*)d_ws + WS_CTL, 0, CTL_ZERO_BYTES, stream) != hipSuccess) return;
    Args a{};
    for (int i = 0; i < 23; ++i) a.in[i] = (const float*)d_in[i];
    a.out = (float*)d_out; a.ws = (unsigned char*)d_ws;
    if (N_LAUNCHES == 1) { a.ph_lo = 0; a.ph_hi = NPHASE; hipLaunchKernelGGL(fwd_kernel, dim3(grid), dim3(NTHREADS), LDS_BYTES, stream, a); }
    else for (int p = 0; p < NPHASE; ++p) { a.ph_lo = p; a.ph_hi = p + 1; hipLaunchKernelGGL(fwd_kernel, dim3(grid), dim3(NTHREADS), LDS_BYTES, stream, a); }
}
```

```cpp
#include <hip/hip_runtime.h>
#include <cstdio>
#include <cstdint>

#ifndef N_LAUNCHES
#define N_LAUNCHES 1
#endif

#define LAS __attribute__((address_space(3)))
#define GAS __attribute__((address_space(1)))
#define AS_GLOBAL(T, p) ((T)(GAS T)(p))
typedef unsigned short bf16_t;
typedef short bf16x8 __attribute__((ext_vector_type(8)));
typedef short s16x4 __attribute__((ext_vector_type(4)));
typedef float f32x2 __attribute__((ext_vector_type(2)));
typedef float f32x4 __attribute__((ext_vector_type(4)));
typedef float f32x16 __attribute__((ext_vector_type(16)));
typedef unsigned u32x2 __attribute__((ext_vector_type(2)));
typedef unsigned u32x4 __attribute__((ext_vector_type(4)));
typedef int i32x4 __attribute__((ext_vector_type(4)));
typedef __bf16 nbf16x2 __attribute__((ext_vector_type(2)));

__device__ __forceinline__ unsigned pk2(float a, float b) { f32x2 v = {a, b}; nbf16x2 r = __builtin_convertvector(v, nbf16x2); return __builtin_bit_cast(unsigned, r); }
__device__ __forceinline__ unsigned pk4f8(float a, float b, float c, float d) {
    a = __builtin_amdgcn_fmed3f(a, -448.f, 448.f); b = __builtin_amdgcn_fmed3f(b, -448.f, 448.f); c = __builtin_amdgcn_fmed3f(c, -448.f, 448.f); d = __builtin_amdgcn_fmed3f(d, -448.f, 448.f);
    int w = 0; w = __builtin_amdgcn_cvt_pk_fp8_f32(a, b, w, false); w = __builtin_amdgcn_cvt_pk_fp8_f32(c, d, w, true); return (unsigned)w; }
__device__ __forceinline__ float bf_lo(unsigned w) { return __uint_as_float(w << 16); }
__device__ __forceinline__ float bf_hi(unsigned w) { return __uint_as_float(w & 0xffff0000u); }
#define LDS_WAIT() asm volatile("s_waitcnt lgkmcnt(0)" ::: "memory")
#define VM_WAIT() asm volatile("s_waitcnt vmcnt(0)" ::: "memory")

constexpr int T = 8192, D = 2048, SEQ = 2048, NB = 4, MEML = 256;
constexpr int DFF = 5632, EFF = 7168, NEXP = 8;
constexpr int ZC = 3840;
constexpr int SWR = 3072;
constexpr float RMS_EPS = 1e-6f;
constexpr int F8S_WGU = 10, F8S_WD = 11, F8S_H = 4, F8S_ACT = 3;
#ifndef F8_GU
#define F8_GU 1
#endif
#ifndef F8_P1
#define F8_P1 1
#endif
#ifndef F8_G0
#define F8_G0 1
#endif
#ifndef F8_Z0
#define F8_Z0 1
#endif
#ifndef F8_DFD
#define F8_DFD 0
#endif
#ifndef F8_DN
#define F8_DN 1
#endif
constexpr int NWAVES = 8, NTHREADS = 512;

constexpr size_t MiB = 1u << 20;
constexpr size_t WS_CTL = 0, CTL_ZERO_BYTES = 1 * MiB;
constexpr size_t WS_TAB = 1 * MiB;
constexpr size_t WS_TOKE = WS_TAB + 256 * 1024;
constexpr size_t WS_TOKW = WS_TOKE + 64 * 1024;
constexpr size_t WS_TOKS = WS_TOKW + 64 * 1024;
constexpr size_t WS_RANK = WS_TOKS + 64 * 1024;
constexpr size_t WS_DFT = 2 * MiB;
constexpr size_t WS_X = 18 * MiB;
constexpr size_t WS_H = 82 * MiB;
constexpr size_t WS_MEMN = 114 * MiB;
constexpr size_t WS_WIN = 122 * MiB;
constexpr size_t WS_WS = 152 * MiB;
constexpr size_t WS_WG = 176 * MiB;
constexpr size_t WS_WMEM = 240 * MiB;
constexpr size_t WS_WBR = 252 * MiB;
constexpr size_t WS_WO = 272 * MiB;
constexpr size_t WS_DGU = 288 * MiB;
constexpr size_t WS_DD = 332 * MiB;
constexpr size_t WS_EGU = 354 * MiB;
constexpr size_t WS_ED = 802 * MiB;
constexpr size_t WS_Z = 1026 * MiB;
constexpr size_t WS_VT = 1086 * MiB;
constexpr size_t WS_UT = 1110 * MiB;
constexpr size_t WS_G = 1134 * MiB;
constexpr size_t WS_KM = 1262 * MiB;
constexpr size_t WS_VMT = 1264 * MiB;
constexpr size_t WS_YA = 1266 * MiB, WS_YB = 1278 * MiB, WS_YC = 1290 * MiB, WS_YM = 1294 * MiB;
constexpr size_t WS_MP = 1306 * MiB;
constexpr size_t WS_OD = 1338 * MiB;
constexpr size_t WS_LSE = 1350 * MiB;
constexpr size_t WS_MG = 1370 * MiB;
constexpr size_t WS_ACT = 1402 * MiB;
constexpr size_t WS_H8 = 1402 * MiB;
constexpr size_t WS_HA = 1026 * MiB;
constexpr size_t WS_EACT = 1091 * MiB;
constexpr size_t WS_OS = 1319 * MiB;
constexpr size_t WS_OS1 = 1447 * MiB;
constexpr size_t WS_END = 1575 * MiB;
static_assert(WS_HA + (size_t)16640 * 2048 * 2 <= WS_EACT && WS_EACT + (size_t)16640 * 7168 * 2 <= WS_OS && WS_OS + (size_t)16384 * 2048 * 4 <= WS_END, "moe map");

constexpr int CW_TMO = 0, CW_CODE = 1;
constexpr int CW_BAR = 4096;
constexpr int CW_Q = 8192;
constexpr int CW_MOE = 15360;
constexpr int CW_HIST = 16384;

constexpr int RING_BYTES = 131072;
constexpr int XTAB_OFF = RING_BYTES;
constexpr int MISC_OFF = XTAB_OFF + 11264;
constexpr int UTAB_OFF = MISC_OFF + 256;
constexpr int LDS_BYTES = 147456;
static_assert(UTAB_OFF + 2048 <= LDS_BYTES, "lds");

#define XB_TMO      128
#define XB_XCNT(j)  (256  + 64 * (j))
#define XB_XSUB(j)  (1280 + 64 * (j))
#define XB_XGEN(j)  (2304 + 64 * (j))
#define XB_TOP      3328
#define XB_TOPGEN   3392
#define XCD_BAR_WORDS 3456
#define XB_SPIN_CAP (1u << 18)
__device__ __forceinline__ unsigned xb_ld(unsigned* p)              { return __hip_atomic_load(p, __ATOMIC_RELAXED, __HIP_MEMORY_SCOPE_AGENT); }
__device__ __forceinline__ unsigned xb_add(unsigned* p, unsigned v) { return __hip_atomic_fetch_add(p, v, __ATOMIC_RELAXED, __HIP_MEMORY_SCOPE_AGENT); }
__device__ __forceinline__ unsigned xb_xcc_id() { return (unsigned)__builtin_amdgcn_s_getreg((3 << 11) | 20) & 0xFu; }
#define XB_SPIN(cond, bar) do { unsigned _sp = 0; while (cond) { __builtin_amdgcn_s_sleep(1); \
    if ((++_sp & 255u) == 0u) { if (xb_ld(&(bar)[XB_TMO])) break; if (_sp > XB_SPIN_CAP) { atomicAdd(&(bar)[XB_TMO], 1u); break; } } } } while (0)
struct XcdBarrier { unsigned* bar; unsigned x; volatile LAS unsigned* st; };
__device__ __forceinline__ XcdBarrier xcd_barrier_post(unsigned* bar, volatile LAS unsigned* st) {
    XcdBarrier b; b.bar = bar; b.x = xb_xcc_id(); b.st = st;
    if (threadIdx.x == 0) (void)xb_add(&bar[XB_XCNT(b.x)], 1u);
    return b;
}
__device__ __forceinline__ void xcd_barrier_complete(unsigned* bar, unsigned x, unsigned& nloc, unsigned& nx) {
    const unsigned G = gridDim.x * gridDim.y * gridDim.z;
    unsigned sum, cnt, mine, sp = 0u;
    for (;;) {
        sum = 0u; cnt = 0u; mine = 0u;
#pragma unroll
        for (unsigned j = 0; j < 16; ++j) { const unsigned c = xb_ld(&bar[XB_XCNT(j)]); sum += c; cnt += (c > 0u) ? 1u : 0u; mine = (j == x) ? c : mine; }
        if (sum == G) break;
        __builtin_amdgcn_s_sleep(1);
        if ((++sp & 255u) == 0u) { if (xb_ld(&bar[XB_TMO])) break; if (sp > XB_SPIN_CAP) { atomicAdd(&bar[XB_TMO], 1u); break; } }
    }
    nloc = mine > 0u ? mine : 1u; nx = cnt > 0u ? cnt : 1u;
}
__device__ __forceinline__ void xcd_barrier(const XcdBarrier& b) {
    asm volatile("s_waitcnt vmcnt(0)" ::: "memory");
    __syncthreads();
    if (threadIdx.x == 0) {
        unsigned* bar = b.bar;
        __builtin_amdgcn_s_waitcnt(0);
        unsigned nloc = b.st[0], nx = b.st[1];
        if (nloc == 0u) { xcd_barrier_complete(bar, b.x, nloc, nx); b.st[0] = nloc; b.st[1] = nx; }
        const unsigned old = xb_add(&bar[XB_XSUB(b.x)], 1u);
        const unsigned gen = old / nloc;
        if (old + 1u == (gen + 1u) * nloc) {
            __builtin_amdgcn_fence(__ATOMIC_RELEASE, "agent");
            asm volatile("s_waitcnt vmcnt(0)" ::: "memory");
            const unsigned og = xb_add(&bar[XB_TOP], 1u);
            const unsigned tg = og / nx;
            if (og + 1u == (tg + 1u) * nx) xb_add(&bar[XB_TOPGEN], 1u);
            else XB_SPIN(xb_ld(&bar[XB_TOPGEN]) == tg, bar);
            __builtin_amdgcn_fence(__ATOMIC_ACQUIRE, "agent");
            xb_add(&bar[XB_XGEN(b.x)], 1u);
            asm volatile("s_waitcnt vmcnt(0)" ::: "memory");
        } else {
            XB_SPIN(xb_ld(&bar[XB_XGEN(b.x)]) == gen, bar);
            __builtin_amdgcn_fence(__ATOMIC_ACQUIRE, "agent");
            asm volatile("s_waitcnt vmcnt(0)" ::: "memory");
        }
    }
    __syncthreads();
}

namespace g8 {
constexpr int BM = 256, BK = 64, HALF = 128, HTB = HALF * BK * 2, STAGE_BYTES = 8 * HTB;
__host__ __device__ __forceinline__ int lds_byte(int r, int c) { const int st = (r >> 4) * 2 + (c >> 5), rr = r & 15, cc = c & 31, ob = rr * 64 + cc * 2; return st * 1024 + (ob ^ (((ob >> 9) & 1) << 5)); }
__host__ __device__ __forceinline__ void stage_rc(int b, int& R, int& C) { const int st = b / 1024, sb = b % 1024, swz = sb ^ (((sb >> 9) & 1) << 5); R = (st >> 1) * 16 + swz / 64; C = (st & 1) * 32 + (swz % 64) / 2; }
__host__ __device__ __forceinline__ int perm32(int rho) { const int n = rho >> 4, i = rho & 15; return 8 * (i >> 2) + 4 * n + (i & 3); }

struct Unit { const char* A; const char* B; char* O; unsigned lda2, ldb2; int ldc; int nt; int kind; int row0, col0, lim; unsigned bmul = 1, bhalf = 128; };

__device__ __forceinline__ void tile_map(int L, int nM, int nN, int& pm, int& pn) {
    const int nwg = nM * nN; const int q = nwg / 8, r = nwg % 8, xcd = L % 8, off = L / 8;
    const int wgid = (xcd < r ? xcd * (q + 1) : r * (q + 1) + (xcd - r) * q) + off;
    const int nig = 8 * nN, gid = wgid / nig, fm = gid * 8, gsz = (nM - fm) < 8 ? (nM - fm) : 8;
    pm = fm + ((wgid % nig) % gsz); pn = (wgid % nig) / gsz;
}

__device__ __forceinline__ const char* uni_ptr(const char* p) { const unsigned long long v = (unsigned long long)p; const unsigned lo = (unsigned)__builtin_amdgcn_readfirstlane((int)(unsigned)v), hi = (unsigned)__builtin_amdgcn_readfirstlane((int)(unsigned)(v >> 32));
    return (const char*)(GAS const char*)(((unsigned long long)hi << 32) | lo); }
template <class Epi, class Sched, bool F8 = false>
__device__ __forceinline__ void gemm_phase(LAS unsigned char* lds, const Sched& S, const Epi& E) {
    int tid_ = threadIdx.x; asm volatile("" : "+v"(tid_));
    const int tid = tid_, wid = __builtin_amdgcn_readfirstlane(tid >> 6), lane = tid & 63, wr = wid >> 2, wc = wid & 3, fr = lane & 15, fq = lane >> 4;
    unsigned spk[2];
#pragma unroll
    for (int i = 0; i < 2; ++i) { int R, C; stage_rc(tid * 16 + i * 8192, R, C); const int Rb = Epi::PERM ? ((R & ~31) + perm32(R & 31)) : R; spk[i] = (unsigned)R | ((unsigned)Rb << 8) | ((unsigned)(C * 2) << 16); }
    const unsigned ldsw = (unsigned)wid * 1024u;
    const int aoff = lds_byte(wr * 64 + fr, fq * 8), boff = lds_byte(wc * 32 + fr, fq * 8);
#define PG8_SA(b, h) (((b) * 2 + (h)) * HTB)
#define PG8_SB(b, h) ((4 + (b) * 2 + (h)) * HTB)
#define PG8_STAGE(bufoff, gbase, voff) do { const char* _gb = uni_ptr((const char*)(gbase)); _Pragma("unroll") for (int _i = 0; _i < 2; ++_i) \
        __builtin_amdgcn_global_load_lds((const unsigned*)(_gb + (voff)[_i]), (LAS unsigned*)(lds + (bufoff) + ldsw + _i * 8192), 16, 0, 0); } while (0)
#define PG8_LDA(dst, b, h) do { _Pragma("unroll") for (int m = 0; m < 4; ++m) _Pragma("unroll") for (int k = 0; k < 2; ++k) dst[m][k] = *(const LAS bf16x8*)(lds + PG8_SA(b, h) + aoff + m * 2048 + k * 1024); } while (0)
#define PG8_LDB(dst, b, h) do { _Pragma("unroll") for (int n = 0; n < 2; ++n) _Pragma("unroll") for (int k = 0; k < 2; ++k) dst[n][k] = *(const LAS bf16x8*)(lds + PG8_SB(b, h) + boff + n * 2048 + k * 1024); } while (0)
#define PG8_CAT(x0, x1) __builtin_shufflevector(__builtin_bit_cast(i32x4, (x0)), __builtin_bit_cast(i32x4, (x1)), 0, 1, 2, 3, 4, 5, 6, 7)
#define PG8_MMA(ai, bj, At, Bt) do { __builtin_amdgcn_s_setprio(1); _Pragma("unroll") for (int m = 0; m < 4; ++m) _Pragma("unroll") for (int n = 0; n < 2; ++n) { \
        if constexpr (F8) acc[ai][bj][m][n] = __builtin_amdgcn_mfma_scale_f32_16x16x128_f8f6f4(PG8_CAT(Bt[n][0], Bt[n][1]), PG8_CAT(At[m][0], At[m][1]), acc[ai][bj][m][n], 0, 0, 0, 0, 0, 0); \
        else { _Pragma("unroll") for (int k = 0; k < 2; ++k) acc[ai][bj][m][n] = __builtin_amdgcn_mfma_f32_16x16x32_bf16(Bt[n][k], At[m][k], acc[ai][bj][m][n], 0, 0, 0); } } __builtin_amdgcn_s_setprio(0); } while (0)
#define PG8_WAIT_V(n) asm volatile("s_waitcnt vmcnt(" #n ")" ::: "memory")
#define PG8_WAIT_L(n) asm volatile("s_waitcnt lgkmcnt(" #n ")" ::: "memory")
#define PG8_BAR __builtin_amdgcn_s_barrier()
#define PG8_SCHED __builtin_amdgcn_sched_barrier(0)
#define PG8_SETV(u_) do { _Pragma("unroll") for (int _i = 0; _i < 2; ++_i) { vA[_i] = (spk[_i] & 255u) * (u_).lda2 + (spk[_i] >> 16); vB[_i] = ((spk[_i] >> 8) & 255u) * ((u_).ldb2 * (u_).bmul) + (spk[_i] >> 16); \
        asm volatile("" : "+v"(vA[_i]), "+v"(vB[_i])); } } while (0)
    int ui = 0, nt;
    const char *uA, *uB; unsigned hA, hB; unsigned vA[2], vB[2];
    { Unit u0; if (!S.next(0, u0)) return; uA = u0.A; uB = u0.B; hA = HALF * u0.lda2; hB = u0.bhalf * u0.ldb2; nt = u0.nt; PG8_SETV(u0); }
    f32x4 acc[2][2][4][2];
#pragma unroll
    for (int a = 0; a < 2; ++a)
#pragma unroll
        for (int b = 0; b < 2; ++b)
#pragma unroll
            for (int m = 0; m < 4; ++m)
#pragma unroll
                for (int n = 0; n < 2; ++n) acc[a][b][m][n] = (f32x4){0.f, 0.f, 0.f, 0.f};
    bf16x8 At[4][2], B0[2][2], B1[2][2];
    const size_t kstep = (size_t)(BK * 2);
    PG8_STAGE(PG8_SB(0, 0), uB, vB); PG8_STAGE(PG8_SB(0, 1), uB + hB, vB); PG8_STAGE(PG8_SA(0, 0), uA, vA); PG8_STAGE(PG8_SA(0, 1), uA + hA, vA);
    if (wr == 1) PG8_BAR;
    PG8_WAIT_V(2); PG8_BAR;
    PG8_STAGE(PG8_SB(1, 0), uB + kstep, vB); PG8_STAGE(PG8_SA(1, 0), uA + kstep, vA); PG8_STAGE(PG8_SB(1, 1), uB + hB + kstep, vB);
    PG8_WAIT_V(6); PG8_BAR;
    for (;;) {
        bool has_next = false; int nnt = nt;
        for (int t = 0; t < nt; t += 2) {
            const bool last = (t == nt - 2);
            PG8_LDB(B0, 0, 0); PG8_LDB(B1, 0, 1); PG8_SCHED; PG8_LDA(At, 0, 0); PG8_STAGE(PG8_SA(1, 1), uA + (size_t)(t + 1) * kstep + hA, vA);
            PG8_WAIT_V(8); PG8_WAIT_L(0); PG8_BAR; PG8_MMA(0, 0, At, B0); PG8_MMA(0, 1, At, B1); PG8_BAR; PG8_SCHED;
            const char *a2, *b2;
            if (last) { Unit nx; has_next = S.next(ui + 1, nx); if (has_next) { uA = nx.A; uB = nx.B; hA = HALF * nx.lda2; hB = nx.bhalf * nx.ldb2; nnt = nx.nt; PG8_SETV(nx); } a2 = uA; b2 = uB; }
            else { a2 = uA + (size_t)(t + 2) * kstep; b2 = uB + (size_t)(t + 2) * kstep; }
            const char* a3 = a2 + kstep; const char* b3 = b2 + kstep;
            PG8_LDA(At, 0, 1); PG8_STAGE(PG8_SB(0, 0), b2, vB); PG8_STAGE(PG8_SB(0, 1), b2 + hB, vB); PG8_STAGE(PG8_SA(0, 0), a2, vA);
            PG8_WAIT_V(8); PG8_WAIT_L(0); PG8_BAR; PG8_MMA(1, 0, At, B0); PG8_MMA(1, 1, At, B1); PG8_BAR; PG8_SCHED;
            PG8_LDB(B0, 1, 0); PG8_LDB(B1, 1, 1); PG8_SCHED; PG8_LDA(At, 1, 0); PG8_STAGE(PG8_SA(0, 1), a2 + hA, vA);
            PG8_WAIT_V(8); PG8_WAIT_L(0); PG8_BAR; PG8_MMA(0, 0, At, B0); PG8_MMA(0, 1, At, B1); PG8_BAR; PG8_SCHED;
            PG8_LDA(At, 1, 1); PG8_STAGE(PG8_SB(1, 0), b3, vB); PG8_STAGE(PG8_SB(1, 1), b3 + hB, vB); PG8_STAGE(PG8_SA(1, 0), a3, vA);
            PG8_WAIT_V(8); PG8_WAIT_L(0); PG8_BAR; PG8_MMA(1, 0, At, B0); PG8_MMA(1, 1, At, B1); PG8_BAR; PG8_SCHED;
        }
        if (wr == 0) PG8_BAR;
        { Unit eu; (void)S.next(ui, eu); int ln = lane; asm volatile("" : "+v"(ln));
          E(acc, eu, wr, wc, ln & 15, ln >> 4); }
        if (!has_next) break;
#pragma unroll
        for (int a = 0; a < 2; ++a)
#pragma unroll
            for (int b = 0; b < 2; ++b)
#pragma unroll
                for (int m = 0; m < 4; ++m)
#pragma unroll
                    for (int n = 0; n < 2; ++n) acc[a][b][m][n] = (f32x4){0.f, 0.f, 0.f, 0.f};
        ++ui; nt = nnt;
        if (wr == 1) PG8_BAR;
    }
    PG8_WAIT_V(0);
    PG8_BAR;
#undef PG8_SETV
#undef PG8_SA
#undef PG8_SB
#undef PG8_STAGE
#undef PG8_LDA
#undef PG8_LDB
#undef PG8_MMA
#undef PG8_CAT
#undef PG8_WAIT_V
#undef PG8_WAIT_L
#undef PG8_BAR
#undef PG8_SCHED
}
}
using g8::Unit;

enum { K_PLAIN = 0, K_ZROT = 1, K_GATE = 2 };

template <bool SC8> struct EpiP1T {
    static constexpr bool PERM = true;
    const float* bgate; const f32x2* rope;
    __device__ __forceinline__ void operator()(const f32x4 (&acc)[2][2][4][2], const Unit& u, int wr, int wc, int fr, int fq) const {
        const int kind = u.kind; const int ldc = u.ldc;
        bf16_t* O = (bf16_t*)u.O;
        const bool rot = (kind == K_ZROT) && (wc == 0);
#pragma unroll
        for (int ai = 0; ai < 2; ++ai)
#pragma unroll
            for (int m = 0; m < 4; ++m) {
                const int r = ai * 128 + wr * 64 + m * 16 + fr;
                bf16_t* rowp = O + (size_t)r * ldc + wc * 32 + 8 * fq;
                f32x4 cs0[2], cs1[2];
                if (rot) { const int pos = (u.row0 + r) & (SEQ - 1); const f32x4* rp = (const f32x4*)(rope + pos * 16 + 8 * (fq & 1)); cs0[0] = rp[0]; cs0[1] = rp[1]; cs1[0] = rp[2]; cs1[1] = rp[3]; }
#pragma unroll
                for (int bj = 0; bj < 2; ++bj) {
                    f32x4 v0 = acc[ai][bj][m][0], v1 = acc[ai][bj][m][1];
                    if constexpr (SC8) { v0 = v0 * (1.f / (float)(1 << (F8S_H + F8S_WGU))); v1 = v1 * (1.f / (float)(1 << (F8S_H + F8S_WGU))); }
                    if (kind == K_GATE) {
                        const float* bp = bgate + u.col0 + bj * 128 + wc * 32 + 8 * fq;
                        const f32x4 b0 = *(const f32x4*)bp, b1 = *(const f32x4*)(bp + 4);
#pragma unroll
                        for (int j = 0; j < 4; ++j) { v0[j] = __builtin_amdgcn_rcpf(1.f + __builtin_amdgcn_exp2f(-(v0[j] + b0[j]) * 1.44269504f)); v1[j] = __builtin_amdgcn_rcpf(1.f + __builtin_amdgcn_exp2f(-(v1[j] + b1[j]) * 1.44269504f)); }
                    }
                    if (rot) {
                        f32x4 p0, p1;
#pragma unroll
                        for (int j = 0; j < 4; ++j) { p0[j] = __shfl_xor(v0[j], 32); p1[j] = __shfl_xor(v1[j], 32); }
                        const float c00 = cs0[0][0], s00 = cs0[0][1], c01 = cs0[0][2], s01 = cs0[0][3], c02 = cs0[1][0], s02 = cs0[1][1], c03 = cs0[1][2], s03 = cs0[1][3];
                        const float c10 = cs1[0][0], s10 = cs1[0][1], c11 = cs1[0][2], s11 = cs1[0][3], c12 = cs1[1][0], s12 = cs1[1][1], c13 = cs1[1][2], s13 = cs1[1][3];
                        const float sg = (fq < 2) ? -1.f : 1.f;
                        v0[0] = v0[0] * c00 + sg * p0[0] * s00; v0[1] = v0[1] * c01 + sg * p0[1] * s01; v0[2] = v0[2] * c02 + sg * p0[2] * s02; v0[3] = v0[3] * c03 + sg * p0[3] * s03;
                        v1[0] = v1[0] * c10 + sg * p1[0] * s10; v1[1] = v1[1] * c11 + sg * p1[1] * s11; v1[2] = v1[2] * c12 + sg * p1[2] * s12; v1[3] = v1[3] * c13 + sg * p1[3] * s13;
                    }
                    u32x4 w; w.x = pk2(v0[0], v0[1]); w.y = pk2(v0[2], v0[3]); w.z = pk2(v1[0], v1[1]); w.w = pk2(v1[2], v1[3]);
                    if (kind == K_GATE) {
                        u32x2 gq;
                        gq.x = (unsigned)(v0[0] * 255.f + 0.5f) | ((unsigned)(v0[1] * 255.f + 0.5f) << 8) | ((unsigned)(v0[2] * 255.f + 0.5f) << 16) | ((unsigned)(v0[3] * 255.f + 0.5f) << 24);
                        gq.y = (unsigned)(v1[0] * 255.f + 0.5f) | ((unsigned)(v1[1] * 255.f + 0.5f) << 8) | ((unsigned)(v1[2] * 255.f + 0.5f) << 16) | ((unsigned)(v1[3] * 255.f + 0.5f) << 24);
                        *(u32x2*)((char*)u.O + (size_t)(((u.row0 >> 8) * 32 + (u.col0 >> 8)) * 16 + (ai * 4 + m) * 2 + bj) * 4096 + ((wr * 4 + wc) * 64 + fq * 16 + fr) * 8) = gq;
                    } else *(u32x4*)(rowp + bj * 128) = w;
                }
            }
    }
};

struct EpiPlain {
    static constexpr bool PERM = true;
    __device__ __forceinline__ void operator()(const f32x4 (&acc)[2][2][4][2], const Unit& u, int wr, int wc, int fr, int fq) const {
        bf16_t* O = (bf16_t*)u.O; const int ldc = u.ldc;
#pragma unroll
        for (int ai = 0; ai < 2; ++ai)
#pragma unroll
            for (int m = 0; m < 4; ++m) {
                bf16_t* rowp = O + (size_t)(ai * 128 + wr * 64 + m * 16 + fr) * ldc + wc * 32 + 8 * fq;
#pragma unroll
                for (int bj = 0; bj < 2; ++bj) { const f32x4 v0 = acc[ai][bj][m][0], v1 = acc[ai][bj][m][1];
                    u32x4 w; w.x = pk2(v0[0], v0[1]); w.y = pk2(v0[2], v0[3]); w.z = pk2(v1[0], v1[1]); w.w = pk2(v1[2], v1[3]); *(u32x4*)(rowp + bj * 128) = w; }
            }
    }
};

struct EpiBranch {
    static constexpr bool PERM = true;
    const char* G; char* PB; bf16_t* MG;
    __device__ __forceinline__ void operator()(const f32x4 (&acc)[2][2][4][2], const Unit& u, int wr, int wc, int fr, int fq) const {
        const int seg = u.kind; const int pm = u.row0 >> 8, pn = u.col0 >> 8;
        const size_t lo_ = (size_t)((wr * 4 + wc) * 64 + fq * 16 + fr) * 16;
        const char* gt = G + (size_t)((pm * 32 + seg * 8 + pn) * 16) * 4096 + (lo_ >> 1);
        char* pt = PB + (size_t)((pm * 8 + pn) * 16) * 8192 + lo_;
#pragma unroll
        for (int ai = 0; ai < 2; ++ai) {
            u32x2 g[4][2]; u32x4 pq[4][2];
#pragma unroll
            for (int m = 0; m < 4; ++m)
#pragma unroll
                for (int bj = 0; bj < 2; ++bj) { const int o = ((ai * 4 + m) * 2 + bj) * 8192; g[m][bj] = *(const u32x2*)(gt + (o >> 1)); if (seg > 0) pq[m][bj] = *(const u32x4*)(pt + o); }
#pragma unroll
            for (int m = 0; m < 4; ++m)
#pragma unroll
                for (int bj = 0; bj < 2; ++bj) {
                    const u32x2 gg = g[m][bj]; constexpr float GS = 1.f / 255.f;
                    f32x4 v0 = acc[ai][bj][m][0], v1 = acc[ai][bj][m][1];
                    v0[0] *= (float)(gg.x & 255u) * GS; v0[1] *= (float)((gg.x >> 8) & 255u) * GS; v0[2] *= (float)((gg.x >> 16) & 255u) * GS; v0[3] *= (float)(gg.x >> 24) * GS;
                    v1[0] *= (float)(gg.y & 255u) * GS; v1[1] *= (float)((gg.y >> 8) & 255u) * GS; v1[2] *= (float)((gg.y >> 16) & 255u) * GS; v1[3] *= (float)(gg.y >> 24) * GS;
                    if (seg > 0) { const u32x4 q = pq[m][bj];
                        v0[0] += bf_lo(q.x); v0[1] += bf_hi(q.x); v0[2] += bf_lo(q.y); v0[3] += bf_hi(q.y); v1[0] += bf_lo(q.z); v1[1] += bf_hi(q.z); v1[2] += bf_lo(q.w); v1[3] += bf_hi(q.w); }
                    u32x4 w; w.x = pk2(v0[0], v0[1]); w.y = pk2(v0[2], v0[3]); w.z = pk2(v1[0], v1[1]); w.w = pk2(v1[2], v1[3]);
                    if (seg < 3) *(u32x4*)(pt + ((ai * 4 + m) * 2 + bj) * 8192) = w;
                    else { const int r = u.row0 + ai * 128 + wr * 64 + m * 16 + fr, c = u.col0 + bj * 128 + wc * 32 + 8 * fq; *(u32x4*)(MG + (size_t)r * D + c) = w; }
                }
        }
    }
};

template <bool SC8> struct EpiResidT {
    static constexpr bool PERM = false;
    const float* Xin; float* Xout; int ldc;
    __device__ __forceinline__ void operator()(const f32x4 (&acc)[2][2][4][2], const Unit& u, int wr, int wc, int fr, int fq) const {
#pragma unroll
        for (int ai = 0; ai < 2; ++ai)
#pragma unroll
            for (int m = 0; m < 4; ++m) {
                const int r = u.row0 + ai * 128 + wr * 64 + m * 16 + fr;
                if (r < u.lim) {
#pragma unroll
                    for (int bj = 0; bj < 2; ++bj)
#pragma unroll
                        for (int n = 0; n < 2; ++n) {
                            const size_t off = (size_t)r * ldc + u.col0 + bj * 128 + wc * 32 + n * 16 + 4 * fq;
                            f32x4 v = acc[ai][bj][m][n]; if constexpr (SC8) v = v * (1.f / (float)(1 << (F8S_ACT + F8S_WD)));
                            if (Xin) v += *(const f32x4*)(Xin + off);
                            *(f32x4*)(Xout + off) = v;
                        }
                }
            }
    }
};
typedef EpiResidT<false> EpiResid;

template <bool MOE> struct EpiSwigluT {
    static constexpr bool PERM = true;
    __device__ __forceinline__ void operator()(const f32x4 (&acc)[2][2][4][2], const Unit& u, int wr, int wc, int fr, int fq) const {
        constexpr bool OUTF8 = MOE ? (F8_DN != 0) : (F8_DFD != 0); constexpr int PITCH = MOE ? EFF : DFF;
        constexpr float sc = (MOE && F8_GU) ? 1.f / (float)(1 << (F8S_H + F8S_WGU)) : 1.f;
#pragma unroll
        for (int ai = 0; ai < 2; ++ai)
#pragma unroll
            for (int m = 0; m < 4; ++m) {
                const int r = u.row0 + ai * 128 + wr * 64 + m * 16 + fr;
                float o[8];
#pragma unroll
                for (int n = 0; n < 2; ++n)
#pragma unroll
                    for (int j = 0; j < 4; ++j) { const float g = acc[ai][0][m][n][j] * sc, uu = acc[ai][1][m][n][j] * sc; o[n * 4 + j] = g * __builtin_amdgcn_rcpf(1.f + __builtin_amdgcn_exp2f(-g * 1.44269504f)) * uu; }
                if (r < u.lim) {
                    if constexpr (OUTF8) { const float q = (float)(1 << F8S_ACT); u32x2 w; w.x = pk4f8(o[0] * q, o[1] * q, o[2] * q, o[3] * q); w.y = pk4f8(o[4] * q, o[5] * q, o[6] * q, o[7] * q);
                        *(u32x2*)(u.O + (size_t)r * PITCH + u.col0 + wc * 32 + 8 * fq) = w; }
                    else { u32x4 w; w.x = pk2(o[0], o[1]); w.y = pk2(o[2], o[3]); w.z = pk2(o[4], o[5]); w.w = pk2(o[6], o[7]);
                        *(u32x4*)((bf16_t*)u.O + (size_t)r * PITCH + u.col0 + wc * 32 + 8 * fq) = w; } }
            }
    }
};

struct SchedP1 {
    int G, c, l; unsigned char* ws; int part = -1;
    __device__ __forceinline__ bool next(int i, Unit& u) const {
        int L = i * G + c;
        if (F8_Z0) { if (part == 0) { if (L >= 384) return false; L += 480; } else if (part == 1) { if (L >= 1528) return false; L = L < 480 ? L : L + 384; } else if (L >= 1912) return false; }
        else if (part == 0) { if (L >= 888) return false; if (L >= 864) L += 1024; } else if (part == 1) { if (L >= 1024) return false; L += 864; } else if (L >= 1912) return false;
        const bool f8 = (F8_P1 && l == 1) || (F8_G0 && l == 0 && part == 1);
        const char* H = (const char*)(ws + ((f8 && l == 0) ? WS_H8 : WS_H)); const char* MEMN = (const char*)(ws + WS_MEMN) + (size_t)l * 1024 * D * 2; const char* WMEM = (const char*)(ws + WS_WMEM) + (size_t)l * 1536 * D * 2;
        const size_t RP = f8 ? 2048 : 4096;
        u.nt = f8 ? 16 : 32; u.lim = 1 << 30; u.kind = K_PLAIN; u.lda2 = (unsigned)RP; u.ldb2 = (unsigned)RP;
        int pm, pn;
        if (L < 480) { g8::tile_map(L, 32, 15, pm, pn); u.A = H + (size_t)pm * 256 * RP; u.B = (const char*)(ws + WS_WIN) + (size_t)l * ZC * D * 2 + (size_t)pn * 256 * RP;
            u.O = (char*)(ws + WS_Z) + ((size_t)pm * 256 * ZC + pn * 256) * 2; u.ldc = ZC; u.row0 = pm * 256; u.col0 = pn * 256; if (pn >= 6 && pn < 12) u.kind = K_ZROT; return true; }
        L -= 480;
        if (L < 384) { g8::tile_map(L, 12, 32, pm, pn); u.A = (const char*)(ws + WS_WS) + (size_t)l * SWR * D * 2 + (size_t)pm * 256 * RP; u.B = H + (size_t)pn * 256 * RP; u.row0 = pm * 256; u.col0 = pn * 256;
            if (pm < 6) { u.O = (char*)(ws + WS_VT) + ((size_t)pm * 256 * T + pn * 256) * 2; u.ldc = T;
                if (pm == 4) { const int b = pn >> 3, q = pn & 7; u.B = H + (size_t)(b * SEQ + 4 * ((q & 1) * 256) + (q >> 1)) * RP; u.bmul = 4; u.bhalf = 512; }
                if (pm == 5) { const int b = pn >> 3, q = pn & 7; u.B = H + (size_t)(b * SEQ + 2 * q) * RP; u.bmul = 16; u.bhalf = 1; } }
            else { const int q = pm - 6, cs = q / 3, n0 = (q % 3) * 256, b = pn >> 3, s0 = (pn & 7) * 256; u.O = (char*)(ws + WS_UT) + (((size_t)(b * 768 + n0)) * 4096 + cs * 2048 + s0) * 2; u.ldc = 4096; }
            return true; }
        L -= 384;
        if (L < 1024) { g8::tile_map(L, 32, 32, pm, pn); u.A = H + (size_t)pm * 256 * RP; u.B = (const char*)(ws + WS_WG) + (size_t)l * 8192 * D * 2 + (size_t)pn * 256 * RP;
            u.O = (char*)(ws + WS_G); u.ldc = 8192; u.row0 = pm * 256; u.col0 = pn * 256; u.kind = K_GATE; return true; }
        L -= 1024;
        if (L < 12) { pm = L % 4; pn = L / 4; u.A = MEMN + (size_t)pm * 256 * RP; u.B = WMEM + (size_t)pn * 256 * RP;
            u.O = (char*)(ws + WS_KM) + ((size_t)pm * 256 * 768 + pn * 256) * 2; u.ldc = 768; u.row0 = pm * 256; u.col0 = pn * 256; return true; }
        L -= 12;
        pm = L % 3; pn = L / 3; u.A = WMEM + (size_t)(768 + pm * 256) * RP; u.B = MEMN + (size_t)pn * 256 * RP;
        u.O = (char*)(ws + WS_VMT) + ((size_t)pm * 256 * 1024 + pn * 256) * 2; u.ldc = 1024; u.row0 = pm * 256; u.col0 = pn * 256; return true;
    }
};
struct SchedDFT {
    int c; unsigned char* ws;
    __device__ __forceinline__ bool next(int i, Unit& u) const {
        if (i > 0 || c >= 96) return false;
        const int b = c / 24, rem = c % 24, pm = rem & 7, pn = rem >> 3;
        u.A = (const char*)(ws + WS_DFT) + (size_t)pm * 256 * 8192; u.B = (const char*)(ws + WS_UT) + (size_t)(b * 768 + pn * 256) * 8192; u.lda2 = 8192; u.ldb2 = 8192; u.nt = 64; u.kind = K_PLAIN; u.lim = 1 << 30;
        u.row0 = b * 2048 + pm * 256; u.col0 = pn * 256; u.O = (char*)(ws + WS_YB) + ((size_t)u.row0 * 768 + u.col0) * 2; u.ldc = 768; return true;
    }
};
struct SchedP3 {
    int G, c, l; unsigned char* ws;
    __device__ __forceinline__ bool next(int i, Unit& u) const {
        const int ti = i >> 2, seg = i & 3; const int L = ti * G + c; if (L >= 256) return false;
        int pm, pn; g8::tile_map(L, 32, 8, pm, pn);
        const int kseg = (seg == 2) ? 256 : 768;
        const size_t ao = seg == 0 ? WS_YA : seg == 1 ? WS_YB : seg == 2 ? WS_YC : WS_YM;
        const size_t wo = seg == 0 ? 0 : seg == 1 ? 3 * MiB : seg == 2 ? 6 * MiB : 7 * MiB;
        u.A = (const char*)(ws + ao) + (size_t)pm * 256 * kseg * 2; u.B = (const char*)(ws + WS_WBR) + (size_t)l * 10 * MiB + wo + (size_t)pn * 256 * kseg * 2; u.lda2 = kseg * 2; u.ldb2 = kseg * 2; u.nt = kseg / 64; u.kind = seg;
        u.row0 = pm * 256; u.col0 = pn * 256; u.lim = 1 << 30; u.O = nullptr; u.ldc = 0; return true;
    }
};
struct SchedSimple {
    int G, c; const char *A, *B; unsigned lda2, ldb2; int nM, nN, nt, colmul; char* O = nullptr;
    __device__ __forceinline__ bool next(int i, Unit& u) const {
        const int L = i * G + c; if (L >= nM * nN) return false;
        int pm, pn; g8::tile_map(L, nM, nN, pm, pn);
        u.A = A + (size_t)pm * 256 * lda2; u.B = B + (size_t)pn * 256 * ldb2; u.lda2 = lda2; u.ldb2 = ldb2; u.nt = nt; u.kind = 0; u.row0 = pm * 256; u.col0 = pn * colmul; u.lim = 1 << 30; u.O = O; u.ldc = 0; return true;
    }
};
struct SchedMoe {
    int G, c; const char *A, *B; unsigned lda2, ldb2; size_t wstride; int nN, nt, colmul; const int* cntp; char* O;
    __device__ __forceinline__ bool next(int i, Unit& u) const {
        int L = i * G + c; int off = 0;
        for (int e = 0; e < 8; ++e) {
            const int ce = cntp[e]; const int rt = (ce + 255) >> 8, nu = rt * nN;
            if (L < nu) { int pm, pn; g8::tile_map(L, rt, nN, pm, pn);
                u.A = A + (size_t)(off + pm * 256) * lda2; u.B = B + (size_t)e * wstride + (size_t)pn * 256 * ldb2; u.lda2 = lda2; u.ldb2 = ldb2; u.nt = nt; u.kind = 0;
                u.row0 = off + pm * 256; u.col0 = pn * colmul; u.lim = off + ce; u.O = O; u.ldc = 0; return true; }
            L -= nu; off += ce;
        }
        return false;
    }
};

struct MoeDownPlan { int rt[8], rtm[8], off[8], cnt[8]; int rounds, R, S, split_start, trows; };
__device__ __forceinline__ void moe_down_plan(const int* cntp, int G, MoeDownPlan& P) {
    int nrt = 0, o = 0;
#pragma unroll
    for (int e = 0; e < 8; ++e) { P.cnt[e] = cntp[e]; P.rt[e] = (P.cnt[e] + 255) >> 8; P.off[e] = o; o += P.cnt[e]; nrt += P.rt[e]; }
    const int NU = nrt * 8; P.R = NU % G; P.rounds = NU / G;
    int sf = P.R > 0 ? G / P.R : 1; P.S = sf >= 7 ? 7 : sf >= 4 ? 4 : sf >= 2 ? 2 : 1;
    int tr = P.R / 8; P.split_start = o;
#pragma unroll
    for (int e = 7; e >= 0; --e) { const int t = tr < P.rt[e] ? tr : P.rt[e]; P.rtm[e] = P.rt[e] - t; tr -= t; if (t > 0) P.split_start = P.off[e] + P.rtm[e] * 256; }
    P.trows = o - P.split_start;
}
struct SchedMoeDown {
    int G, c; const char *A, *B; unsigned lda2, ldb2; size_t wstride; int ntu; const int* cntp; char *O0, *PB;
    __device__ __forceinline__ bool next(int i, Unit& u) const {
        MoeDownPlan P; moe_down_plan(cntp, G, P);
        u.lda2 = lda2; u.ldb2 = ldb2; u.kind = 0; u.ldc = D;
        if (i < P.rounds) {
            int L = i * G + c;
#pragma unroll
            for (int e = 0; e < 8; ++e) { const int nu = P.rtm[e] * 8;
                if (L < nu) { int pm, pn; g8::tile_map(L, P.rtm[e], 8, pm, pn);
                    u.row0 = P.off[e] + pm * 256; u.col0 = pn * 256; u.lim = P.off[e] + P.cnt[e]; u.nt = ntu;
                    u.A = A + (size_t)u.row0 * lda2; u.B = B + (size_t)e * wstride + (size_t)pn * 256 * ldb2; u.O = O0 + (size_t)u.row0 * D * 2; return true; }
                L -= nu; }
            return false;
        }
        if (i > P.rounds || c >= P.R * P.S) return false;
        const int ut = c / P.S, part = c - ut * P.S, pn = ut & 7; int q = ut >> 3; const int ntp = ntu / P.S;
#pragma unroll
        for (int e = 0; e < 8; ++e) { const int te = P.rt[e] - P.rtm[e];
            if (q < te) { const int pm = P.rtm[e] + q;
                u.row0 = P.off[e] + pm * 256; u.col0 = pn * 256; u.lim = P.off[e] + P.cnt[e]; u.nt = ntp;
                u.A = A + (size_t)u.row0 * lda2 + (size_t)(part * ntp) * 128; u.B = B + (size_t)e * wstride + (size_t)pn * 256 * ldb2 + (size_t)(part * ntp) * 128;
                u.O = PB + ((size_t)part * P.trows + (u.row0 - P.split_start)) * D * 4; u.kind = 1; return true; }
            q -= te; }
        return false;
    }
};
struct EpiMoeDown {
    static constexpr bool PERM = false;
    __device__ __forceinline__ void operator()(const f32x4 (&acc)[2][2][4][2], const Unit& u, int wr, int wc, int fr, int fq) const {
        float* O = (float*)u.O;
#pragma unroll
        for (int ai = 0; ai < 2; ++ai)
#pragma unroll
            for (int m = 0; m < 4; ++m) {
                const int rl = ai * 128 + wr * 64 + m * 16 + fr;
                if (u.row0 + rl < u.lim) {
#pragma unroll
                    for (int bj = 0; bj < 2; ++bj)
#pragma unroll
                        for (int n = 0; n < 2; ++n) { const f32x4 v = acc[ai][bj][m][n] * (F8_DN ? 1.f / (float)(1 << (F8S_ACT + F8S_WD)) : 1.f); const size_t off = (size_t)rl * D + u.col0 + bj * 128 + wc * 32 + n * 16 + 4 * fq;
                            if (u.kind) *(f32x4*)(O + off) = v; else { u32x2 w; w.x = pk2(v.x, v.y); w.y = pk2(v.z, v.w); *(u32x2*)((bf16_t*)u.O + off) = w; } }
                }
            }
    }
};

struct UnitTab {
    const LAS u32x4* tab;
    __device__ __forceinline__ bool next(int i, Unit& u) const {
        if (i >= 32) return false;
        const u32x4 q0 = tab[i * 4 + 0], q1 = tab[i * 4 + 1], q2 = tab[i * 4 + 2], q3 = tab[i * 4 + 3];
#define RFL(x) ((unsigned)__builtin_amdgcn_readfirstlane((int)(x)))
        u.nt = (int)RFL(q2.y); if (u.nt == 0) return false;
        u.A = (const char*)(GAS const char*)(((unsigned long long)RFL(q0.y) << 32) | RFL(q0.x)); u.B = (const char*)(GAS const char*)(((unsigned long long)RFL(q0.w) << 32) | RFL(q0.z)); u.O = (char*)(GAS char*)(((unsigned long long)RFL(q1.y) << 32) | RFL(q1.x));
        u.lda2 = RFL(q1.z); u.ldb2 = RFL(q1.w); u.ldc = (int)RFL(q2.x); u.kind = (int)RFL(q2.z); u.row0 = (int)RFL(q2.w); u.col0 = (int)RFL(q3.x); u.lim = (int)RFL(q3.y); u.bmul = RFL(q3.z); u.bhalf = RFL(q3.w);
#undef RFL
        return true;
    }
};
template <class Sched> __device__ __forceinline__ UnitTab build_units(LAS unsigned char* lds, const Sched& S) {
    LAS u32x4* tab = (LAS u32x4*)(lds + UTAB_OFF);
    __syncthreads();
    if (threadIdx.x < 32) { Unit u; const bool ok = S.next((int)threadIdx.x, u); const int t = threadIdx.x;
        const unsigned long long a = (unsigned long long)u.A, b = (unsigned long long)u.B, o = (unsigned long long)u.O;
        tab[t * 4 + 0] = (u32x4){(unsigned)a, (unsigned)(a >> 32), (unsigned)b, (unsigned)(b >> 32)};
        tab[t * 4 + 1] = (u32x4){(unsigned)o, (unsigned)(o >> 32), u.lda2, u.ldb2};
        tab[t * 4 + 2] = (u32x4){(unsigned)u.ldc, ok ? (unsigned)u.nt : 0u, (unsigned)u.kind, (unsigned)u.row0};
        tab[t * 4 + 3] = (u32x4){(unsigned)u.col0, (unsigned)u.lim, u.bmul, u.bhalf}; }
    __syncthreads();
    UnitTab T_; T_.tab = tab; return T_;
}

struct Args { const float* in[23]; float* out; unsigned char* ws; int ph_lo, ph_hi; };
typedef const __attribute__((address_space(4))) Args* KArgsPtr;
__device__ __forceinline__ KArgsPtr kargs() { unsigned long long p = (unsigned long long)__builtin_amdgcn_kernarg_segment_ptr(); asm volatile("" : "+s"(p)); return (KArgsPtr)p; }
struct Frame {
    LAS unsigned char* lds; volatile LAS unsigned* MISC;
    int tid, lane, wave, G, bx;
};
__device__ __forceinline__ float wave_sum(float v) {
#pragma unroll
    for (int o = 1; o < 64; o <<= 1) v += __shfl_xor(v, o);
    return v;
}

struct TrJob { const float* src; bf16_t* dst; int ldn, K, mode, k0, n0, f8; };
__device__ __forceinline__ void tr_load(const TrJob& j, f32x4 (&v)[8], int lane) {
    const float* src = j.src + (size_t)(j.k0 + (lane >> 3)) * j.ldn + j.n0 + 4 * (lane & 7);
#pragma unroll
    for (int i = 0; i < 8; ++i) v[i] = *(const f32x4*)(src + (size_t)(8 * i) * j.ldn);
}
__device__ __forceinline__ void tr_store(const TrJob& j, const f32x4 (&v)[8], LAS float* scr, int lane) {
#pragma unroll
    for (int i = 0; i < 8; ++i)
#pragma unroll
        for (int e = 0; e < 4; ++e) scr[(8 * i + (lane >> 3)) * 33 + 4 * (lane & 7) + e] = v[i][e];
    LDS_WAIT(); asm volatile("" ::: "memory");
    const int c = lane & 7;
    if (j.f8) {
        const float sc = (float)(1 << j.f8);
#pragma unroll
        for (int q = 0; q < 4; ++q) { const int n = (lane >> 3) + 8 * q; const LAS float* s = scr + (8 * c) * 33 + n;
            u32x2 o; o.x = pk4f8(s[0 * 33] * sc, s[1 * 33] * sc, s[2 * 33] * sc, s[3 * 33] * sc); o.y = pk4f8(s[4 * 33] * sc, s[5 * 33] * sc, s[6 * 33] * sc, s[7 * 33] * sc);
            const int nn = j.n0 + n; const int drow = j.mode == 0 ? nn : ((nn >> 7) * 256 + (j.mode == 2 ? 128 : 0) + (nn & 127));
            *(u32x2*)((char*)j.dst + (size_t)drow * j.K + j.k0 + 8 * c) = o; }
    } else {
#pragma unroll
    for (int q = 0; q < 4; ++q) { const int n = (lane >> 3) + 8 * q; const LAS float* s = scr + (8 * c) * 33 + n;
        u32x4 o; o.x = pk2(s[0 * 33], s[1 * 33]); o.y = pk2(s[2 * 33], s[3 * 33]); o.z = pk2(s[4 * 33], s[5 * 33]); o.w = pk2(s[6 * 33], s[7 * 33]);
        const int nn = j.n0 + n; const int drow = j.mode == 0 ? nn : ((nn >> 7) * 256 + (j.mode == 2 ? 128 : 0) + (nn & 127));
        *(u32x4*)(j.dst + (size_t)drow * j.K + j.k0 + 8 * c) = o; }
    }
    LDS_WAIT(); asm volatile("" ::: "memory");
}
__device__ __forceinline__ void rms_row_bf16(const float* xrow, const float* gain, bf16_t* orow, int lane) {
    const f32x4* xr = (const f32x4*)xrow + lane; const f32x4* gr = (const f32x4*)gain + lane;
    f32x4 v[8]; float s = 0.f;
#pragma unroll
    for (int j = 0; j < 8; ++j) { v[j] = xr[64 * j]; s += (v[j].x * v[j].x + v[j].y * v[j].y) + (v[j].z * v[j].z + v[j].w * v[j].w); }
    const float rstd = __builtin_amdgcn_rsqf(wave_sum(s) * (1.f / D) + RMS_EPS);
    u32x2* o8 = (u32x2*)orow + lane;
#pragma unroll
    for (int j = 0; j < 8; ++j) { const f32x4 g = gr[64 * j]; u32x2 w; w.x = pk2(v[j].x * rstd * g.x, v[j].y * rstd * g.y); w.y = pk2(v[j].z * rstd * g.z, v[j].w * rstd * g.w); o8[64 * j] = w; }
}
__device__ __forceinline__ void rms_row_f8(const float* xrow, const float* gain, unsigned char* orow, int lane) {
    const f32x4* xr = (const f32x4*)xrow + lane; const f32x4* gr = (const f32x4*)gain + lane;
    f32x4 v[8]; float s = 0.f;
#pragma unroll
    for (int j = 0; j < 8; ++j) { v[j] = xr[64 * j]; s += (v[j].x * v[j].x + v[j].y * v[j].y) + (v[j].z * v[j].z + v[j].w * v[j].w); }
    const float rstd = __builtin_amdgcn_rsqf(wave_sum(s) * (1.f / D) + RMS_EPS) * (float)(1 << F8S_H);
    unsigned* o4 = (unsigned*)orow + lane;
#pragma unroll
    for (int j = 0; j < 8; ++j) { const f32x4 g = gr[64 * j]; o4[64 * j] = pk4f8(v[j].x * rstd * g.x, v[j].y * rstd * g.y, v[j].z * rstd * g.z, v[j].w * rstd * g.w); }
}
__device__ __forceinline__ void rms_row_bf16_f8(const float* xrow, const float* gain, bf16_t* orow, unsigned char* orow8, int lane) {
    const f32x4* xr = (const f32x4*)xrow + lane; const f32x4* gr = (const f32x4*)gain + lane;
    f32x4 v[8]; float s = 0.f;
#pragma unroll
    for (int j = 0; j < 8; ++j) { v[j] = xr[64 * j]; s += (v[j].x * v[j].x + v[j].y * v[j].y) + (v[j].z * v[j].z + v[j].w * v[j].w); }
    const float rstd = __builtin_amdgcn_rsqf(wave_sum(s) * (1.f / D) + RMS_EPS);
    u32x2* o8 = (u32x2*)orow + lane; unsigned* o4 = (unsigned*)orow8 + lane; const float q = (float)(1 << F8S_H);
#pragma unroll
    for (int j = 0; j < 8; ++j) { const f32x4 g = gr[64 * j]; const float a = v[j].x * rstd * g.x, b = v[j].y * rstd * g.y, c = v[j].z * rstd * g.z, d = v[j].w * rstd * g.w;
        u32x2 w; w.x = pk2(a, b); w.y = pk2(c, d); o8[64 * j] = w; o4[64 * j] = pk4f8(a * q, b * q, c * q, d * q); }
}
__constant__ float ROPE_F[16] = {1.591549431e-01f, 7.008652159e-02f, 3.086376340e-02f, 1.359137064e-02f, 5.985185713e-03f, 2.635675899e-03f, 1.160663641e-03f, 5.111175045e-04f,
                                 2.250790790e-04f, 9.911730937e-05f, 4.364795279e-05f, 1.922110068e-05f, 8.464330808e-06f, 3.727408602e-06f, 1.641426263e-06f, 7.228293069e-07f};

constexpr int CV_I_E = (D / 64) * (EFF / 32), CV_I_ED = (EFF / 64) * (D / 32), CV_I_EXP = 8 * (2 * CV_I_E + CV_I_ED);
constexpr int N_FILL = 36;
constexpr int FILL1_BLK0 = 120, FILL3_BLK0 = 128;
constexpr int N_FILL2 = 6;
constexpr int FILL1A_BLK0 = (F8_G0 && F8_Z0) ? 128 : FILL1_BLK0;
constexpr int N_DEF1A = (256 - FILL1A_BLK0) * NWAVES * N_FILL;
constexpr int N_DEF1 = (256 - FILL1_BLK0) * NWAVES * N_FILL, N_DEF3 = (256 - FILL3_BLK0) * NWAVES * N_FILL, N_DEF2 = 160 * NWAVES * N_FILL2, N_DEFER = N_DEF1A + N_DEF1 + N_DEF3 + 2 * N_DEF2;
static_assert(N_DEFER < CV_I_EXP, "deferred items are expert items");
static_assert(N_FILL % 2 == 0 && N_FILL2 % 2 == 0 && N_DEF1 % 2 == 0 && N_DEF2 % 2 == 0 && N_DEF3 % 2 == 0 && CV_I_E % 2 == 0 && CV_I_ED % 2 == 0 && NWAVES % 2 == 0, "fp8 item pairs (2i, 2i+1) stay inside one workgroup");
__device__ __forceinline__ void expert_item_job(int r, TrJob& J) {
    KArgsPtr kb = kargs(); unsigned char* wsb = (unsigned char*)(GAS unsigned char*)kb->ws;
    const int e = r / (2 * CV_I_E + CV_I_ED); r -= e * (2 * CV_I_E + CV_I_ED);
    const float* src; bf16_t* dst; int ldn, K, ncols, mode;
    if (r < CV_I_E) { src = ((const float*)(GAS const float*)kb->in[19]) + (size_t)e * D * EFF; ldn = EFF; K = D; ncols = EFF; dst = (bf16_t*)(wsb + WS_EGU + (size_t)e * 14336 * D * (F8_GU ? 1 : 2)); mode = 1; }
    else if (r < 2 * CV_I_E) { r -= CV_I_E; src = ((const float*)(GAS const float*)kb->in[20]) + (size_t)e * D * EFF; ldn = EFF; K = D; ncols = EFF; dst = (bf16_t*)(wsb + WS_EGU + (size_t)e * 14336 * D * (F8_GU ? 1 : 2)); mode = 2; }
    else { r -= 2 * CV_I_E; src = ((const float*)(GAS const float*)kb->in[21]) + (size_t)e * EFF * D; ldn = D; K = EFF; ncols = D; dst = (bf16_t*)(wsb + WS_ED + (size_t)e * D * EFF * (F8_DN ? 1 : 2)); mode = 0; }
    const int g8 = (K >> 6) * 8, g = r / g8, rem = r - g * g8, kbk = 2 * (rem >> 4) + (rem & 1), nb = g * 8 + ((rem >> 1) & 7); (void)ncols;
    J.src = src; J.dst = dst; J.ldn = ldn; J.K = K; J.mode = mode; J.k0 = 64 * kbk; J.n0 = 32 * nb; J.f8 = mode == 0 ? (F8_DN ? F8S_WD : 0) : (F8_GU ? F8S_WGU : 0);
}
__device__ __forceinline__ void cvt_fill(Frame& F, int first, int cnt = N_FILL) {
    int lane_ = (int)threadIdx.x; asm volatile("" : "+v"(lane_)); lane_ &= 63;
    LAS float* scr = (LAS float*)(F.lds + F.wave * 16384);
#define LOADJ(J, V, K_) do { const int k_ = (K_); expert_item_job(first + (k_ < cnt ? k_ : cnt - 1), J); tr_load(J, V, lane_); } while (0)
#pragma unroll 1
    for (int k = 0; k < cnt; k += 4) {
        TrJob ja, jb, jc, jd; f32x4 a[8], b[8], c[8], d[8];
        LOADJ(ja, a, k); LOADJ(jb, b, k + 1); LOADJ(jc, c, k + 2); LOADJ(jd, d, k + 3);
        tr_store(ja, a, scr, lane_); if (k + 1 < cnt) tr_store(jb, b, scr, lane_); if (k + 2 < cnt) tr_store(jc, c, scr, lane_); if (k + 3 < cnt) tr_store(jd, d, scr, lane_);
    }
#undef LOADJ
}
__device__ __forceinline__ void p0_prologue(Frame& F) {
    LAS float* scr = (LAS float*)(F.lds + F.wave * 16384);
    LAS f32x2* trig = (LAS f32x2*)(F.lds + XTAB_OFF);
    if (F.tid < 128) { const float a = (float)F.tid * (1.f / 64.f); trig[F.tid] = (f32x2){cospif(a) * 0.08838834765f, sinpif(a) * 0.08838834765f}; }
    __syncthreads();
    int lane_ = (int)threadIdx.x; asm volatile("" : "+v"(lane_)); lane_ &= 63;
    const int gw = F.bx * NWAVES + F.wave, NGW = F.G * NWAVES, lane = lane_;
    KArgsPtr ka = kargs(); unsigned char* ws = (unsigned char*)(GAS unsigned char*)ka->ws;
    for (int it = gw; it < 768; it += NGW) {
        const int l = it / 384, rem = it % 384, g = rem / 64, k0 = (rem % 64) * 32;
        const float* W = ((const float*)(GAS const float*)ka->in[3]) + (size_t)l * D * 6144 + 4608 + g * 128;
#pragma unroll 8
        for (int kk = 0; kk < 32; ++kk) { const f32x2 w = *(const f32x2*)(W + (size_t)(k0 + kk) * 6144 + 2 * lane); *(LAS f32x2*)(scr + kk * 128 + 2 * lane) = w; }
        LDS_WAIT(); asm volatile("" ::: "memory");
        bf16_t* dst = (bf16_t*)(ws + WS_WS) + (size_t)l * SWR * D + (size_t)(1536 + g * 128) * D;
        for (int kc = 0; kc < 4; ++kc) {
            float a[2][2][8];
#pragma unroll
            for (int p = 0; p < 2; ++p)
#pragma unroll
                for (int q = 0; q < 2; ++q)
#pragma unroll
                    for (int k = 0; k < 8; ++k) a[p][q][k] = 0.f;
            for (int c = 0; c < 128; ++c) {
                const f32x2 t0 = trig[(c * lane) & 127], t1 = trig[(c * (lane + 64)) & 127];
#pragma unroll
                for (int k = 0; k < 8; ++k) { const float w = scr[(kc * 8 + k) * 128 + c]; a[0][0][k] += w * t0.x; a[0][1][k] += w * t0.y; a[1][0][k] += w * t1.x; a[1][1][k] += w * t1.y; }
            }
#pragma unroll
            for (int p = 0; p < 2; ++p)
#pragma unroll
                for (int q = 0; q < 2; ++q) {
                    if (F8_P1 && l == 1) { const float sc = (float)(1 << F8S_WGU); u32x2 o; o.x = pk4f8(a[p][q][0] * sc, a[p][q][1] * sc, a[p][q][2] * sc, a[p][q][3] * sc); o.y = pk4f8(a[p][q][4] * sc, a[p][q][5] * sc, a[p][q][6] * sc, a[p][q][7] * sc);
                        *(u32x2*)((char*)(ws + WS_WS) + (size_t)l * SWR * D * 2 + (size_t)(1536 + g * 128 + q * 768 + lane + 64 * p) * D + k0 + kc * 8) = o; }
                    else { u32x4 o; o.x = pk2(a[p][q][0], a[p][q][1]); o.y = pk2(a[p][q][2], a[p][q][3]); o.z = pk2(a[p][q][4], a[p][q][5]); o.w = pk2(a[p][q][6], a[p][q][7]);
                        *(u32x4*)(dst + (size_t)(q * 768 + lane + 64 * p) * D + k0 + kc * 8) = o; } }
        }
        LDS_WAIT(); asm volatile("" ::: "memory");
    }
    for (int it = gw; it < 2048; it += NGW) {
        bf16_t* row = (bf16_t*)(ws + WS_DFT) + (size_t)it * 4096;
#pragma unroll 2
        for (int j = 0; j < 8; ++j) { const int c0 = 8 * (lane + 64 * j); float v[8];
#pragma unroll
            for (int e = 0; e < 8; ++e) { const int cc = c0 + e, k = cc & 2047; const float a = (float)((it * k) & 2047) * (1.f / 1024.f); v[e] = (cc < 2048 ? cospif(a) : -sinpif(a)) * 0.02209708691f; }
            u32x4 o; o.x = pk2(v[0], v[1]); o.y = pk2(v[2], v[3]); o.z = pk2(v[4], v[5]); o.w = pk2(v[6], v[7]); *(u32x4*)(row + c0) = o; }
    }
    for (int it = gw; it < 512; it += NGW) {
        const int pos = it * 4 + (lane >> 4), i = lane & 15; const float f = ROPE_F[i], p = (float)pos;
        const float hi = p * f, lo = fmaf(p, f, -hi); const float fr = (hi - floorf(hi)) + lo;
        ((f32x2*)(ws + WS_TAB))[pos * 16 + i] = (f32x2){cospif(2.f * fr), sinpif(2.f * fr)};
    }
    for (int it = gw; it < T + 2 * 1024; it += NGW) {
        if (it < T) { if (F8_G0) rms_row_bf16_f8(((const float*)(GAS const float*)ka->in[0]) + (size_t)it * D, ((const float*)(GAS const float*)ka->in[2]), (bf16_t*)(ws + WS_H) + (size_t)it * D, (unsigned char*)(ws + WS_H8) + (size_t)it * D, lane);
            else rms_row_bf16(((const float*)(GAS const float*)ka->in[0]) + (size_t)it * D, ((const float*)(GAS const float*)ka->in[2]), (bf16_t*)(ws + WS_H) + (size_t)it * D, lane); }
        else { const int l = (it - T) >> 10, r = (it - T) & 1023;
            if ((F8_P1 && l == 1) || (F8_G0 && F8_Z0 && l == 0)) rms_row_f8(((const float*)(GAS const float*)ka->in[1]) + (size_t)r * D, ((const float*)(GAS const float*)ka->in[5]) + l * D, (unsigned char*)(ws + WS_MEMN) + (size_t)l * 1024 * D * 2 + (size_t)r * D, lane);
            else rms_row_bf16(((const float*)(GAS const float*)ka->in[1]) + (size_t)r * D, ((const float*)(GAS const float*)ka->in[5]) + l * D, (bf16_t*)(ws + WS_MEMN) + ((size_t)l * 1024 + r) * D, lane); }
    }
    constexpr int I_E = (D / 64) * (EFF / 32), I_ED = (EFF / 64) * (D / 32);
    constexpr int I_EXP = 8 * (2 * I_E + I_ED);
    constexpr int I_DG = (D / 64) * (DFF / 32), I_DDN = (DFF / 64) * (D / 32);
    constexpr int I_IN1 = 32 * (1536 / 32), I_IN2 = 32 * (768 / 32), I_MEM = 32 * (1536 / 32), I_BR = 12 * 64, I_BRC = 4 * 64, I_GT = 32 * 256, I_WO = 32 * 64;
    constexpr int I_LAYER = I_IN1 + I_IN2 + I_IN1 + I_IN2 + I_IN2 + I_MEM + 3 * I_BR + I_BRC + I_GT + I_WO;
    constexpr int NITEMS = I_EXP + 2 * I_DG + I_DDN + 2 * I_LAYER;
    auto decode = [&](int it, TrJob& J) {
        KArgsPtr kb = kargs(); unsigned char* wsb = (unsigned char*)(GAS unsigned char*)kb->ws;
        int r = it; const float* src = nullptr; bf16_t* dst = nullptr; int ldn = 0, K = 0, col0 = 0, ncols = 32, mode = 0; bool done = false, p1f8 = false; const bool isexp0 = it < I_EXP || (F8_DFD && it >= I_EXP + 2 * I_DG && it < I_EXP + 2 * I_DG + I_DDN);
#define TJ(n_, src_, ldn_, K_, col0_, ncols_, dst_, mode_) if (!done) { if (r < (n_)) { src = (src_); ldn = (ldn_); K = (K_); col0 = (col0_); ncols = (ncols_); dst = (dst_); mode = (mode_); done = true; } else r -= (n_); }
        if (r < I_EXP) { const int e = r / (2 * I_E + I_ED); r -= e * (2 * I_E + I_ED);
            TJ(I_E, ((const float*)(GAS const float*)kb->in[19]) + (size_t)e * D * EFF, EFF, D, 0, EFF, (bf16_t*)(wsb + WS_EGU + (size_t)e * 14336 * D * (F8_GU ? 1 : 2)), 1)
            TJ(I_E, ((const float*)(GAS const float*)kb->in[20]) + (size_t)e * D * EFF, EFF, D, 0, EFF, (bf16_t*)(wsb + WS_EGU + (size_t)e * 14336 * D * (F8_GU ? 1 : 2)), 2)
            TJ(I_ED, ((const float*)(GAS const float*)kb->in[21]) + (size_t)e * EFF * D, D, EFF, 0, D, (bf16_t*)(wsb + WS_ED + (size_t)e * D * EFF * (F8_DN ? 1 : 2)), 0)
        } else { r -= I_EXP;
            TJ(I_DG, ((const float*)(GAS const float*)kb->in[15]), DFF, D, 0, DFF, (bf16_t*)(wsb + WS_DGU), 1)
            TJ(I_DG, ((const float*)(GAS const float*)kb->in[16]), DFF, D, 0, DFF, (bf16_t*)(wsb + WS_DGU), 2)
            TJ(I_DDN, ((const float*)(GAS const float*)kb->in[17]), D, DFF, 0, D, (bf16_t*)(wsb + WS_DD), 0)
            if (!done) { const int l = r / I_LAYER; r -= l * I_LAYER; const bool p1 = F8_P1 && l == 1, pz = p1 || (F8_G0 && F8_Z0 && l == 0);
#define ROF(f_, base_, rows_) ((f_) ? (bf16_t*)((char*)(base_) + (size_t)(rows_) * D) : (base_) + (size_t)(rows_) * D)
#define TJP(f_, n_, src_, ldn_, K_, col0_, ncols_, dst_, mode_) if (!done) { if (r < (n_)) { src = (src_); ldn = (ldn_); K = (K_); col0 = (col0_); ncols = (ncols_); dst = (dst_); mode = (mode_); p1f8 = (f_); done = true; } else r -= (n_); }
                bf16_t* WINl = (bf16_t*)(wsb + WS_WIN) + (size_t)l * ZC * D; bf16_t* WSl = (bf16_t*)(wsb + WS_WS) + (size_t)l * SWR * D; unsigned char* wbr = wsb + WS_WBR + (size_t)l * 10 * MiB;
                const float* win = ((const float*)(GAS const float*)kb->in[3]) + (size_t)l * D * 6144;
                TJP(pz, I_IN1, win, 6144, D, 0, 1536, WINl, 0)
                TJP(p1, I_IN2, win, 6144, D, 1536, 768, WSl, 0)
                TJP(pz, I_IN1, win, 6144, D, 2304, 1536, ROF(pz, WINl, 1536), 0)
                TJP(p1, I_IN2, win, 6144, D, 3840, 768, ROF(p1, WSl, 768), 0)
                TJP(pz, I_IN2, win, 6144, D, 5376, 768, ROF(pz, WINl, 3072), 0)
                TJP(pz, I_MEM, ((const float*)(GAS const float*)kb->in[6]) + (size_t)l * D * 1536, 1536, D, 0, 1536, (bf16_t*)(wsb + WS_WMEM) + (size_t)l * 1536 * D, 0)
                TJ(I_BR, ((const float*)(GAS const float*)kb->in[7]) + (size_t)l * 768 * D, D, 768, 0, D, (bf16_t*)(wbr), 0)
                TJ(I_BR, ((const float*)(GAS const float*)kb->in[8]) + (size_t)l * 768 * D, D, 768, 0, D, (bf16_t*)(wbr + 3 * MiB), 0)
                TJ(I_BRC, ((const float*)(GAS const float*)kb->in[9]) + (size_t)l * 256 * D, D, 256, 0, D, (bf16_t*)(wbr + 6 * MiB), 0)
                TJ(I_BR, ((const float*)(GAS const float*)kb->in[10]) + (size_t)l * 768 * D, D, 768, 0, D, (bf16_t*)(wbr + 7 * MiB), 0)
                if (!done) { if (r < I_GT) { src = ((const float*)(GAS const float*)kb->in[11]) + (size_t)l * D * 8192; ldn = 8192; K = D; col0 = 0; ncols = 8192; dst = (bf16_t*)(wsb + WS_WG) + (size_t)l * 8192 * D; mode = 0; p1f8 = p1 || (F8_G0 && l == 0); done = true; } else r -= I_GT; }
                TJ(I_WO, ((const float*)(GAS const float*)kb->in[13]) + (size_t)l * D * D, D, D, 0, D, (bf16_t*)(wsb + WS_WO) + (size_t)l * D * D, 0)
            }
        }
#undef TJ
#undef TJP
#undef ROF
        const bool isexp = isexp0 || p1f8; const int g8 = (K >> 6) * 8, g = r / g8, rem = r - g * g8, kbk = isexp ? 2 * (rem >> 4) + (rem & 1) : rem >> 3, nb = g * 8 + (isexp ? (rem >> 1) & 7 : rem & 7); (void)ncols;
        J.src = src + col0; J.dst = dst; J.ldn = ldn; J.K = K; J.mode = mode; J.k0 = 64 * kbk; J.n0 = 32 * nb; J.f8 = it < I_EXP ? (mode == 0 ? (F8_DN ? F8S_WD : 0) : (F8_GU ? F8S_WGU : 0)) : p1f8 ? F8S_WGU : isexp0 ? F8S_WD : 0;
    };
    const int ndef = (F.G == 256) ? N_DEFER : 0;
    const int NLIST = NITEMS - ndef, DEF0 = I_EXP - ndef;
    static_assert(I_EXP == CV_I_EXP, "item counts");
    { const int n = (NLIST - gw + NGW - 1) / NGW;
#define LOADJ(J, V, K_) do { int i_ = gw + (K_) * NGW; i_ = i_ < NLIST ? i_ : NLIST - 1; decode(i_ < DEF0 ? i_ : i_ + ndef, J); tr_load(J, V, lane); } while (0)
#pragma unroll 1
      for (int k = 0; k < n; k += 4) {
          TrJob ja, jb, jc, jd; f32x4 a[8], b[8], c[8], d[8];
          LOADJ(ja, a, k); LOADJ(jb, b, k + 1); LOADJ(jc, c, k + 2); LOADJ(jd, d, k + 3);
          tr_store(ja, a, scr, lane); if (k + 1 < n) tr_store(jb, b, scr, lane); if (k + 2 < n) tr_store(jc, c, scr, lane); if (k + 3 < n) tr_store(jd, d, scr, lane);
      }
#undef LOADJ
    }
}

#define MFMA32(a, b, c) __builtin_amdgcn_mfma_f32_32x32x16_bf16((a), (b), (c), 0, 0, 0)
__device__ __forceinline__ int kperm(int r) { return (r & ~12) | ((r & 4) << 1) | ((r & 8) >> 1); }
__device__ __forceinline__ int acc_key(int i, int h) { return (i & 3) + 4 * ((i >> 2) & 1) + 8 * h + 16 * (i >> 3); }
template <int HD> struct AttnSt { f32x16 o[HD / 32]; float m, l; };
template <int HD> __device__ __forceinline__ void attn_init(AttnSt<HD>& st) {
#pragma unroll
    for (int b = 0; b < HD / 32; ++b)
#pragma unroll
        for (int i = 0; i < 16; ++i) st.o[b][i] = 0.f;
    st.m = -1e30f; st.l = 0.f;
}
template <int HD> __device__ __forceinline__ void load_k(bf16x8 (&kf)[HD / 16], const bf16_t* kp) {
#pragma unroll
    for (int kk = 0; kk < HD / 16; ++kk) kf[kk] = *(const bf16x8*)(kp + 16 * kk);
}
template <int HD> __device__ __forceinline__ void load_v(bf16x8 (&vf)[HD / 32][2], const bf16_t* vp, size_t ldv) {
#pragma unroll
    for (int b = 0; b < HD / 32; ++b)
#pragma unroll
        for (int h2 = 0; h2 < 2; ++h2) vf[b][h2] = *(const bf16x8*)(vp + (size_t)(32 * b) * ldv + 16 * h2);
}
template <int HD> __device__ __forceinline__ f32x16 attn_qk(const bf16x8 (&kf)[HD / 16], const bf16x8 (&qf)[HD / 16]) {
    f32x16 x;
#pragma unroll
    for (int i = 0; i < 16; ++i) x[i] = 0.f;
#pragma unroll
    for (int kk = 0; kk < HD / 16; ++kk) x = MFMA32(kf[kk], qf[kk], x);
    return x;
}
template <int HD, class MaskF>
__device__ __forceinline__ float attn_softmax(AttnSt<HD>& st, const f32x16& x, float sc, const MaskF& mf, bf16x8 (&xs)[2]) {
    float s[16]; bool ok[16]; float mt = -1e30f;
#pragma unroll
    for (int i = 0; i < 16; ++i) { float bias; ok[i] = mf(i, bias); s[i] = x[i] * sc + bias; mt = fmaxf(mt, ok[i] ? s[i] : -1e30f); }
    mt = fmaxf(mt, __shfl_xor(mt, 32));
    const float mn = fmaxf(st.m, mt), alpha = __builtin_amdgcn_exp2f(st.m - mn);
    float ps = 0.f; float p[16];
#pragma unroll
    for (int i = 0; i < 16; ++i) { p[i] = ok[i] ? __builtin_amdgcn_exp2f(s[i] - mn) : 0.f; ps += p[i]; }
    st.l = st.l * alpha + ps; st.m = mn;
#pragma unroll
    for (int h2 = 0; h2 < 2; ++h2) { u32x4 w; w.x = pk2(p[8 * h2 + 0], p[8 * h2 + 1]); w.y = pk2(p[8 * h2 + 2], p[8 * h2 + 3]); w.z = pk2(p[8 * h2 + 4], p[8 * h2 + 5]); w.w = pk2(p[8 * h2 + 6], p[8 * h2 + 7]); xs[h2] = __builtin_bit_cast(bf16x8, w); }
    return alpha;
}
template <int HD>
__device__ __forceinline__ void attn_pvmm(AttnSt<HD>& st, const bf16x8 (&vf)[HD / 32][2], const bf16x8 (&xs)[2], float alpha) {
#pragma unroll
    for (int b = 0; b < HD / 32; ++b) {
#pragma unroll
        for (int i = 0; i < 16; ++i) st.o[b][i] *= alpha;
#pragma unroll
        for (int h2 = 0; h2 < 2; ++h2) st.o[b] = MFMA32(vf[b][h2], xs[h2], st.o[b]);
    }
}
template <int HD, class MaskF>
__device__ __forceinline__ void attn_pv(AttnSt<HD>& st, const f32x16& x, const bf16x8 (&vf)[HD / 32][2], float sc, const MaskF& mf) {
    bf16x8 xs[2]; const float alpha = attn_softmax<HD>(st, x, sc, mf, xs); attn_pvmm<HD>(st, vf, xs, alpha);
}
template <int HD, class MaskF>
__device__ __forceinline__ void attn_pv_gv(AttnSt<HD>& st, const f32x16& x, const bf16_t* vp, size_t ldv, float sc, const MaskF& mf) {
    bf16x8 v0 = *(const bf16x8*)(vp), v1 = *(const bf16x8*)(vp + 16);
    float s[16]; bool ok[16]; float mt = -1e30f;
#pragma unroll
    for (int i = 0; i < 16; ++i) { float bias; ok[i] = mf(i, bias); s[i] = x[i] * sc + bias; mt = fmaxf(mt, ok[i] ? s[i] : -1e30f); }
    mt = fmaxf(mt, __shfl_xor(mt, 32));
    const float mn = fmaxf(st.m, mt), alpha = __builtin_amdgcn_exp2f(st.m - mn);
    float ps = 0.f; float p[16];
#pragma unroll
    for (int i = 0; i < 16; ++i) { p[i] = ok[i] ? __builtin_amdgcn_exp2f(s[i] - mn) : 0.f; ps += p[i]; }
    st.l = st.l * alpha + ps; st.m = mn;
    bf16x8 xs[2];
#pragma unroll
    for (int h2 = 0; h2 < 2; ++h2) { u32x4 w; w.x = pk2(p[8 * h2 + 0], p[8 * h2 + 1]); w.y = pk2(p[8 * h2 + 2], p[8 * h2 + 3]); w.z = pk2(p[8 * h2 + 4], p[8 * h2 + 5]); w.w = pk2(p[8 * h2 + 6], p[8 * h2 + 7]); xs[h2] = __builtin_bit_cast(bf16x8, w); }
#pragma unroll
    for (int b = 0; b < HD / 32; ++b) {
        bf16x8 n0 = v0, n1 = v1;
        if (b + 1 < HD / 32) { n0 = *(const bf16x8*)(vp + (size_t)(32 * (b + 1)) * ldv); n1 = *(const bf16x8*)(vp + (size_t)(32 * (b + 1)) * ldv + 16); }
#pragma unroll
        for (int i = 0; i < 16; ++i) st.o[b][i] *= alpha;
        st.o[b] = MFMA32(v0, xs[0], st.o[b]); st.o[b] = MFMA32(v1, xs[1], st.o[b]);
        v0 = n0; v1 = n1;
    }
}
template <int HD> __device__ __forceinline__ void attn_store(const AttnSt<HD>& st, bf16_t* yq  ) {
    const float lt = st.l + __shfl_xor(st.l, 32); const float inv = 1.f / lt;
#pragma unroll
    for (int b = 0; b < HD / 32; ++b)
#pragma unroll
        for (int g = 0; g < 4; ++g) { u32x2 w; w.x = pk2(st.o[b][4 * g] * inv, st.o[b][4 * g + 1] * inv); w.y = pk2(st.o[b][4 * g + 2] * inv, st.o[b][4 * g + 3] * inv); *(u32x2*)(yq + 32 * b + 8 * g) = w; }
}

__device__ __forceinline__ void fetch_tile128(LAS unsigned char* wb, const bf16_t* kt, unsigned ldk, const bf16_t* vt, unsigned ldv, int lane) {
    const unsigned a = (unsigned)lane >> 4, cl = (unsigned)lane & 15u;
    unsigned kvo[4];
#pragma unroll
    for (int i = 0; i < 4; ++i) kvo[i] = a * ldk * 2u + ((cl ^ ((4u * i + a) & 15u)) << 4);
#pragma unroll
    for (int i = 0; i < 8; ++i) {
        const int kp_c = 4 * ((i >> 1) & 1) + 8 * (i & 1) + 16 * (i >> 2);
        const char* kb_ = g8::uni_ptr((const char*)(kt + (size_t)kp_c * ldk));
        __builtin_amdgcn_global_load_lds((const unsigned*)(kb_ + kvo[i & 3]), (LAS unsigned*)(wb + i * 1024), 16, 0, 0);
    }
    const unsigned vvo = ((unsigned)lane >> 2) * ldv * 2u + ((((unsigned)lane & 3u) ^ (((unsigned)lane >> 4) & 3u)) << 4);
#pragma unroll
    for (int i = 0; i < 8; ++i) {
        const char* vb_ = g8::uni_ptr((const char*)(vt + (size_t)(16 * i) * ldv));
        __builtin_amdgcn_global_load_lds((const unsigned*)(vb_ + vvo), (LAS unsigned*)(wb + 8192 + i * 1024), 16, 0, 0);
    }
}
__device__ __forceinline__ void fetch_part128(LAS unsigned char* sb, const bf16_t* kt, unsigned ldk, const bf16_t* vt, unsigned ldv, int lane, int i) {
    const unsigned a = (unsigned)lane >> 4, cl = (unsigned)lane & 15u;
    const unsigned kvo = a * ldk * 2u + ((cl ^ ((4u * (unsigned)i + a) & 15u)) << 4);
    const int kp_c = 4 * ((i >> 1) & 1) + 8 * (i & 1) + 16 * (i >> 2);
    const char* kb_ = g8::uni_ptr((const char*)(kt + (size_t)kp_c * ldk));
    __builtin_amdgcn_global_load_lds((const unsigned*)(kb_ + kvo), (LAS unsigned*)(sb + i * 1024), 16, 0, 0);
    const unsigned vvo = ((unsigned)lane >> 2) * ldv * 2u + ((((unsigned)lane & 3u) ^ (((unsigned)lane >> 4) & 3u)) << 4);
    const char* vb_ = g8::uni_ptr((const char*)(vt + (size_t)(16 * i) * ldv));
    __builtin_amdgcn_global_load_lds((const unsigned*)(vb_ + vvo), (LAS unsigned*)(sb + 8192 + i * 1024), 16, 0, 0);
}
__device__ __forceinline__ void read_tile128(bf16x8 (&kf)[8], bf16x8 (&vf)[4][2], const LAS unsigned char* wb, int r, int h) {
    const LAS unsigned char* kr = wb + r * 256; const int rx = r & 15;
#pragma unroll
    for (int kk = 0; kk < 8; ++kk) kf[kk] = *(const LAS bf16x8*)(kr + (((2 * kk + h) ^ rx) << 4));
    const LAS unsigned char* vr = wb + 8192 + r * 64; const int vx = (r >> 2) & 3;
#pragma unroll
    for (int b = 0; b < 4; ++b)
#pragma unroll
        for (int s2 = 0; s2 < 2; ++s2) vf[b][s2] = *(const LAS bf16x8*)(vr + b * 2048 + (((2 * s2 + h) ^ vx) << 4));
}

__device__ __forceinline__ void fetch_k128(LAS unsigned char* wb, const bf16_t* kt, unsigned ldk, int lane) {
    const unsigned a = (unsigned)lane >> 4, cl = (unsigned)lane & 15u;
    unsigned kvo[4];
#pragma unroll
    for (int i = 0; i < 4; ++i) kvo[i] = a * ldk * 2u + ((cl ^ ((4u * i + a) & 15u)) << 4);
#pragma unroll
    for (int i = 0; i < 8; ++i) {
        const int kp_c = 4 * ((i >> 1) & 1) + 8 * (i & 1) + 16 * (i >> 2);
        const char* kb_ = g8::uni_ptr((const char*)(kt + (size_t)kp_c * ldk));
        __builtin_amdgcn_global_load_lds((const unsigned*)(kb_ + kvo[i & 3]), (LAS unsigned*)(wb + i * 1024), 16, 0, 0);
    }
}
__device__ __forceinline__ void fetch_v128(LAS unsigned char* wb, const bf16_t* vt, unsigned ldv, int lane) {
    const unsigned vvo = ((unsigned)lane >> 2) * ldv * 2u + ((((unsigned)lane & 3u) ^ (((unsigned)lane >> 4) & 3u)) << 4);
#pragma unroll
    for (int i = 0; i < 8; ++i) {
        const char* vb_ = g8::uni_ptr((const char*)(vt + (size_t)(16 * i) * ldv));
        __builtin_amdgcn_global_load_lds((const unsigned*)(vb_ + vvo), (LAS unsigned*)(wb + 8192 + i * 1024), 16, 0, 0);
    }
}
__device__ __forceinline__ void read_k128(bf16x8 (&kf)[8], const LAS unsigned char* wb, int r, int h) {
    const LAS unsigned char* kr = wb + r * 256; const int rx = r & 15;
#pragma unroll
    for (int kk = 0; kk < 8; ++kk) kf[kk] = *(const LAS bf16x8*)(kr + (((2 * kk + h) ^ rx) << 4));
}
__device__ __forceinline__ void read_v128(bf16x8 (&vf)[4][2], const LAS unsigned char* wb, int r, int h) {
    const LAS unsigned char* vr = wb + 8192 + r * 64; const int vx = (r >> 2) & 3;
#pragma unroll
    for (int b = 0; b < 4; ++b)
#pragma unroll
        for (int s2 = 0; s2 < 2; ++s2) vf[b][s2] = *(const LAS bf16x8*)(vr + b * 2048 + (((2 * s2 + h) ^ vx) << 4));
}
__device__ __forceinline__ void fetch_k192(LAS unsigned char* wb, const bf16_t* kt, unsigned ldk, int lane) {
#pragma unroll
    for (int i = 0; i < 12; ++i) {
        const unsigned p_ = 64u * i + (unsigned)lane, rho = p_ / 24u, cp = p_ - rho * 24u;
        const unsigned c = (cp & ~7u) | ((cp & 7u) ^ (rho & 7u)), kr = (rho & ~12u) | ((rho & 4u) << 1) | ((rho & 8u) >> 1);
        __builtin_amdgcn_global_load_lds((const unsigned*)((const char*)kt + (size_t)(kr * ldk * 2u + c * 16u)), (LAS unsigned*)(wb + i * 1024), 16, 0, 0);
    }
}
__device__ __forceinline__ void fetch_v192(LAS unsigned char* wb, const bf16_t* vt, unsigned ldv, int lane) {
    const unsigned vvo = ((unsigned)lane >> 2) * ldv * 2u + ((((unsigned)lane & 3u) ^ (((unsigned)lane >> 4) & 3u)) << 4);
#pragma unroll
    for (int i = 0; i < 12; ++i) {
        const char* vb_ = g8::uni_ptr((const char*)(vt + (size_t)(16 * i) * ldv));
        __builtin_amdgcn_global_load_lds((const unsigned*)(vb_ + vvo), (LAS unsigned*)(wb + i * 1024), 16, 0, 0);
    }
}
__device__ __forceinline__ void read_k192(bf16x8 (&kf)[12], const LAS unsigned char* wb, int r, int h) {
    const LAS unsigned char* kr = wb + r * 384; const int rx = r & 7;
#pragma unroll
    for (int kk = 0; kk < 12; ++kk) { const int c = 2 * kk + h; kf[kk] = *(const LAS bf16x8*)(kr + (((c & ~7) | ((c & 7) ^ rx)) << 4)); }
}
__device__ __forceinline__ void read_v192(bf16x8 (&vf)[6][2], const LAS unsigned char* wb, int r, int h) {
    const LAS unsigned char* vr = wb + r * 64; const int vx = (r >> 2) & 3;
#pragma unroll
    for (int b = 0; b < 6; ++b)
#pragma unroll
        for (int s2 = 0; s2 < 2; ++s2) vf[b][s2] = *(const LAS bf16x8*)(vr + b * 2048 + (((2 * s2 + h) ^ vx) << 4));
}
__device__ __forceinline__ void fetch_piece192(LAS unsigned char* sb, const bf16_t* kt, unsigned ldk, const bf16_t* vt, unsigned ldv, int lane, int idx) {
    if (idx < 12) {
        const unsigned p_ = 64u * (unsigned)idx + (unsigned)lane, rho = p_ / 24u, cp = p_ - rho * 24u;
        const unsigned c = (cp & ~7u) | ((cp & 7u) ^ (rho & 7u)), kr = (rho & ~12u) | ((rho & 4u) << 1) | ((rho & 8u) >> 1);
        __builtin_amdgcn_global_load_lds((const unsigned*)((const char*)kt + (size_t)(kr * ldk * 2u + c * 16u)), (LAS unsigned*)(sb + idx * 1024), 16, 0, 0);
    } else {
        const int i = idx - 12;
        const unsigned vvo = ((unsigned)lane >> 2) * ldv * 2u + ((((unsigned)lane & 3u) ^ (((unsigned)lane >> 4) & 3u)) << 4);
        const char* vb_ = g8::uni_ptr((const char*)(vt + (size_t)(16 * i) * ldv));
        __builtin_amdgcn_global_load_lds((const unsigned*)(vb_ + vvo), (LAS unsigned*)(sb + 12288 + i * 1024), 16, 0, 0);
    }
}
__device__ __forceinline__ void attn_store_lse(const AttnSt<128>& st, bf16_t* yq, float* lse, int h) {
    const float lt = st.l + __shfl_xor(st.l, 32); const float inv = 1.f / lt;
#pragma unroll
    for (int b = 0; b < 4; ++b)
#pragma unroll
        for (int g = 0; g < 4; ++g) { u32x2 w; w.x = pk2(st.o[b][4 * g] * inv, st.o[b][4 * g + 1] * inv); w.y = pk2(st.o[b][4 * g + 2] * inv, st.o[b][4 * g + 3] * inv); *(u32x2*)(yq + 32 * b + 8 * g) = w; }
    if (h == 0) *lse = st.m + __builtin_amdgcn_logf(lt);
}
struct MaskWin { int h, uq, u0;
    __device__ __forceinline__ bool operator()(int i, float& b) const { const int d = u0 + acc_key(i, h) - uq; b = 0.f; return (d <= 64) && (d >= -64); } };
struct MaskNone { __device__ __forceinline__ bool operator()(int, float& b) const { b = 0.f; return true; } };
struct MaskNA { int h, cq, c0, jk0; const LAS float* rp;
    __device__ __forceinline__ bool operator()(int i, float& b) const { const int jk = jk0 + acc_key(i, h); const bool ok = (jk >= c0) && (jk < c0 + 16); const int dc = ok ? (jk - cq + 15) : 0; b = rp[dc]; return ok; } };
struct MaskDil { int h, q, k0, dg;
    __device__ __forceinline__ bool operator()(int i, float& b) const { const int k = k0 + acc_key(i, h); const int d = k - q; b = 0.f; return (d <= 64 * dg) && (d >= -64 * dg) && ((d & (dg - 1)) == 0); } };

__device__ __forceinline__ void attn_phase(Frame& F, unsigned char* ws, int l, int qidx, int part = 0) {
    int lane_ = (int)threadIdx.x; asm volatile("" : "+v"(lane_)); lane_ &= 63;
    const int lane = lane_, r = lane & 31, h = lane >> 5, rk = kperm(r);
    LAS unsigned char* wb = F.lds + F.wave * 16384;
    const bf16_t* Z = (const bf16_t*)(ws + WS_Z); const bf16_t* VT = (const bf16_t*)(ws + WS_VT);
    const LAS float* rpb = (const LAS float*)(F.lds + XTAB_OFF);
    const bool tuned = (F.G == 256);
    const int xg = F.bx & 7, ar = tuned ? (F.bx - 96) >> 3 : 0;
    constexpr float SC128 = 0.08838834765f * 1.44269504f, SC192 = 0.07216878365f * 1.44269504f;
    (void)qidx;
    if (tuned && F.bx < 96) return;
    {
        const int w = F.wave;
        const int nbj = tuned ? (ar < 4 ? 3 : ar < 16 ? 4 : 3) : 0;
        for (int ji_ = 0, jp = tuned ? 0 : F.bx; part != 4 && (tuned ? ji_ < nbj : jp < 576); ++ji_, jp += F.G) {
            int pj;
            if (tuned) {
                if (ar < 4) pj = ji_ == 0 ? ar : ji_ == 1 ? 20 + ar : 40 + ar;
                else pj = ji_ == 0 ? ar : ji_ == 1 ? 24 + (ar - 4) : ji_ == 2 ? 56 + (ar - 4) : 40 + ar; }
            else pj = jp % 72;
            const int xq = tuned ? xg : jp / 72;
            __syncthreads();
            if (pj < 24) { const int jl = pj;
            const int grp = 3 * xq + (jl >> 3), R0 = 4 * (jl & 7), b = grp / 6, hd = grp % 6;
            const int gr = R0 + (w >> 1), half = w & 1;
            const int cq = 32 * half + r; int c0 = cq - 8; c0 = c0 < 0 ? 0 : (c0 > 48 ? 48 : c0);
            int r0q = gr - 4; r0q = r0q < 0 ? 0 : (r0q > 24 ? 24 : r0q);
            int krlo = R0 - 4; krlo = krlo < 0 ? 0 : (krlo > 24 ? 24 : krlo); int krhi = R0 - 1; krhi = (krhi < 0 ? 0 : (krhi > 24 ? 24 : krhi)) + 8;
            const int ntl = (krhi - krlo) * 2;
            const int tq = b * SEQ + gr * 64 + cq;
            bf16x8 qf[8], kf[8], vf[4][2];
            { const bf16_t* qp = Z + (size_t)tq * ZC + hd * 128 + 8 * h;
#pragma unroll
              for (int kk = 0; kk < 8; ++kk) qf[kk] = *(const bf16x8*)(qp + 16 * kk); }
            const bf16_t* kb = Z + (size_t)(b * SEQ + krlo * 64) * ZC + 768 + hd * 128;
            const bf16_t* vb = VT + (size_t)(hd * 128) * T + b * SEQ + krlo * 64;
#pragma unroll
            for (int t = 0; t < 3; ++t) fetch_part128(F.lds + t * 16384, kb + (size_t)(32 * t) * ZC, (unsigned)ZC, vb + 32 * t, (unsigned)T, lane, w);
            AttnSt<128> st; attn_init(st);
#pragma unroll 1
            for (int t = 0; t < ntl; ++t) {
                asm volatile("s_waitcnt vmcnt(4)" ::: "memory");
                __builtin_amdgcn_s_barrier();
                asm volatile("" ::: "memory");
                { const int tn = t + 3 < ntl ? t + 3 : ntl - 1;
                  fetch_part128(F.lds + ((t + 3) & 3) * 16384, kb + (size_t)(32 * tn) * ZC, (unsigned)ZC, vb + 32 * tn, (unsigned)T, lane, w); }
                const int kr = krlo + (t >> 1);
                if (kr >= r0q && kr < r0q + 8) {
                    read_tile128(kf, vf, F.lds + (t & 3) * 16384, r, h);
                    LDS_WAIT();
                    const f32x16 x = attn_qk<128>(kf, qf);
                    MaskNA mf{h, cq, c0, 32 * (t & 1), rpb + (hd * 15 + (kr - gr + 7)) * 31};
                    attn_pv<128>(st, x, vf, SC128, mf);
                }
            }
            attn_store<128>(st, (bf16_t*)(ws + WS_YA) + (size_t)tq * 768 + hd * 128 + 4 * h);
            } else if (pj >= 56) {
                const int mj = xq * 16 + (pj - 56), q8 = mj & 7, hd = (mj >> 3) & 3, b = mj >> 5;
                const int tq = b * SEQ + q8 * 256 + w * 32 + r;
                bf16x8 qf[12];
                { const bf16_t* qp = Z + (size_t)tq * ZC + 3072 + hd * 192 + 8 * h;
#pragma unroll
                  for (int kk = 0; kk < 12; ++kk) qf[kk] = *(const bf16x8*)(qp + 16 * kk); }
                const bf16_t* kb = (const bf16_t*)(ws + WS_KM) + (size_t)(b * MEML) * 768 + hd * 192;
                const bf16_t* vb = (const bf16_t*)(ws + WS_VMT) + (size_t)(hd * 192) * 1024 + b * MEML;
#pragma unroll
                for (int t = 0; t < 3; ++t)
#pragma unroll
                    for (int k3 = 0; k3 < 3; ++k3) fetch_piece192(F.lds + t * 24576, kb + (size_t)(32 * t) * 768, 768u, vb + 32 * t, 1024u, lane, w + 8 * k3);
                AttnSt<192> st; attn_init(st);
#pragma unroll 1
                for (int t = 0; t < 8; ++t) {
                    asm volatile("s_waitcnt vmcnt(6)" ::: "memory");
                    __builtin_amdgcn_s_barrier();
                    asm volatile("" ::: "memory");
                    { const int tn = t + 3 < 8 ? t + 3 : 7;
#pragma unroll
                      for (int k3 = 0; k3 < 3; ++k3) fetch_piece192(F.lds + ((t + 3) & 3) * 24576, kb + (size_t)(32 * tn) * 768, 768u, vb + 32 * tn, 1024u, lane, w + 8 * k3); }
                    const LAS unsigned char* sb = F.lds + (t & 3) * 24576;
                    f32x16 x;
                    { bf16x8 kf[12];
                      read_k192(kf, sb, r, h); LDS_WAIT();
#pragma unroll
                      for (int i = 0; i < 16; ++i) x[i] = 0.f;
#pragma unroll
                      for (int kk = 0; kk < 12; ++kk) x = MFMA32(kf[kk], qf[kk], x); }
                    MaskNone mf; bf16x8 xs[2];
                    const float alpha = attn_softmax<192>(st, x, SC192, mf, xs);
                    bf16x8 vf[6][2];
                    read_v192(vf, sb + 12288, r, h); LDS_WAIT();
                    attn_pvmm<192>(st, vf, xs, alpha);
                }
                attn_store<192>(st, (bf16_t*)(ws + WS_YM) + (size_t)tq * 768 + hd * 192 + 4 * h);
            } else {
                const int b = xq >> 1, hh = xq & 1, di = pj - 24;
                const int g = di < 8 ? 0 : di < 16 ? 1 : 2; const int dg = g == 0 ? 1 : g == 1 ? 4 : 16, sl = g == 0 ? 2048 : g == 1 ? 512 : 128;
                const int cls = g == 0 ? 0 : g == 1 ? ((di - 8) >> 1) : (di - 16), q8 = g == 0 ? di : g == 1 ? ((di - 8) & 1) : 0;
                const int hd = g * 2 + hh, qt = 8 * q8 + w; const bool active = 32 * qt < sl;
                const int uq = 32 * qt + r, tq = b * SEQ + cls + dg * (active ? uq : 0);
                int ulo = 256 * q8 - 64; if (ulo < 0) ulo = 0; int uhi = 256 * q8 + 320; if (uhi > sl) uhi = sl; const int ntl = (uhi - ulo) >> 5;
                bf16x8 qf[8], kf[8], vf[4][2];
                { const bf16_t* qp = Z + (size_t)tq * ZC + 1536 + hd * 128 + 8 * h;
#pragma unroll
                  for (int kk = 0; kk < 8; ++kk) qf[kk] = *(const bf16x8*)(qp + 16 * kk); }
                const bf16_t* kb = Z + (size_t)(b * SEQ + cls + dg * ulo) * ZC + 2304 + hd * 128;
                const bf16_t* vb = VT + (size_t)(768 + hd * 128) * T + b * SEQ + cls * sl + ulo;
#pragma unroll
                for (int t = 0; t < 3; ++t) fetch_part128(F.lds + t * 16384, kb + (size_t)(32 * t * dg) * ZC, (unsigned)(dg * ZC), vb + 32 * t, (unsigned)T, lane, w);
                AttnSt<128> st; attn_init(st);
#pragma unroll 1
                for (int t = 0; t < ntl; ++t) {
                    asm volatile("s_waitcnt vmcnt(4)" ::: "memory");
                    __builtin_amdgcn_s_barrier();
                    asm volatile("" ::: "memory");
                    { const int tn = t + 3 < ntl ? t + 3 : ntl - 1;
                      fetch_part128(F.lds + ((t + 3) & 3) * 16384, kb + (size_t)(32 * tn * dg) * ZC, (unsigned)(dg * ZC), vb + 32 * tn, (unsigned)T, lane, w); }
                    const int u0 = ulo + 32 * t;
                    if (active && u0 >= 32 * qt - 64 && u0 <= 32 * qt + 64) {
                        read_tile128(kf, vf, F.lds + (t & 3) * 16384, r, h);
                        LDS_WAIT();
                        const f32x16 x = attn_qk<128>(kf, qf);
                        MaskWin mf{h, uq, u0};
                        attn_pv<128>(st, x, vf, SC128, mf);
                    }
                }
                if (active) attn_store_lse(st, (bf16_t*)(ws + WS_OD) + ((size_t)(tq * 3 + g) * 2 + hh) * 128 + 4 * h, (float*)(ws + WS_LSE) + (size_t)(tq * 3 + g) * 2 + hh, h);
            }
        }
        VM_WAIT(); __syncthreads();
    }
}

constexpr int NPHASE = 21;

#ifndef PHASE_MASK
#define PHASE_MASK 0x1fffff
#endif
#define GRID_BAR() do { if (N_LAUNCHES == 1) xcd_barrier(bar); } while (0)
#define IN(k) ((((PHASE_MASK) >> ((k) % 32)) & 1) && lo <= (k) && (k) < hi)
#define BOTH(k) (IN(k) && IN((k) + 1))
#if defined(PROBE_A)
#define CW_STAMP 16384
#define STAMP(k) do { if (F.bx == 0 && F.tid == 0) ((volatile unsigned long long*)((unsigned*)(GAS unsigned*)(kargs()->ws + WS_CTL) + CW_STAMP))[(k)] = __builtin_amdgcn_s_memrealtime(); } while (0)
#else
#define STAMP(k) do { } while (0)
#endif
#define PHASE_END(k) do { if (BOTH(k)) { GRID_BAR(); STAMP((k) + 1); } } while (0)
#define PHASE_ENV() KArgsPtr ka = kargs(); unsigned char* ws = (unsigned char*)(GAS unsigned char*)ka->ws; int lane_ = (int)threadIdx.x; asm volatile("" : "+v"(lane_)); lane_ &= 63; const int gw = F.bx * NWAVES + F.wave, NGW = F.G * NWAVES, lane = lane_; (void)gw; (void)NGW; (void)lane
template <int l, int REP> __device__ __forceinline__ void mixer_phases(Frame& F, const XcdBarrier& bar, const int lo, const int hi) {
        const int pb = 1 + 9 * l;
        if (IN(pb)) {
            PHASE_ENV();
            SchedP1 S; S.G = F.G; S.c = F.bx; S.l = l; S.ws = ws;
            constexpr bool P1F8 = (F8_P1 != 0) && l == 1, G0F8 = (F8_G0 != 0) && l == 0;
            if constexpr (G0F8) {
                { S.part = 0; EpiP1T<false> E; E.bgate = ((const float*)(GAS const float*)ka->in[12]) + (size_t)l * 8192; E.rope = (const f32x2*)(ws + WS_TAB);
                  const UnitTab UT_ = build_units(F.lds, S); g8::gemm_phase<EpiP1T<false>, UnitTab, false>(F.lds, UT_, E); }
                { KArgsPtr kc = kargs(); S.part = 1; EpiP1T<true> E; E.bgate = ((const float*)(GAS const float*)kc->in[12]) + (size_t)l * 8192; E.rope = (const f32x2*)(ws + WS_TAB);
                  const UnitTab UT_ = build_units(F.lds, S); g8::gemm_phase<EpiP1T<true>, UnitTab, true>(F.lds, UT_, E); }
            } else {
            EpiP1T<P1F8> E; E.bgate = ((const float*)(GAS const float*)ka->in[12]) + (size_t)l * 8192; E.rope = (const f32x2*)(ws + WS_TAB);
            { const UnitTab UT_ = build_units(F.lds, S); g8::gemm_phase<EpiP1T<P1F8>, UnitTab, P1F8>(F.lds, UT_, E); }
            }
            { constexpr int B0 = l == 0 ? FILL1A_BLK0 : FILL1_BLK0; if (REP == 0 && F.G == 256 && F.bx >= B0) cvt_fill(F, CV_I_EXP - N_DEFER + l * N_DEF1A + ((F.bx - B0) * NWAVES + F.wave) * N_FILL); }
            PHASE_END(pb);
        }
        if (IN(pb + 1)) {
            PHASE_ENV();
            { LAS float* rpb = (LAS float*)(F.lds + XTAB_OFF); const float* src = ((const float*)(GAS const float*)ka->in[4]) + (size_t)l * 2790; for (int i = F.tid; i < 2790; i += NTHREADS) rpb[i] = src[i] * 1.44269504f; }
            __syncthreads();
#ifndef REPEAT_SUB
#define REPEAT_SUB 0
#endif
            if (!(REP == 1 && REPEAT_SUB >= 2)) { SchedDFT S; S.c = F.bx; S.ws = ws;
              EpiPlain E;
              { const UnitTab UT_ = build_units(F.lds, S); g8::gemm_phase<EpiPlain, UnitTab>(F.lds, UT_, E); } }
            if (!(REP == 1 && REPEAT_SUB == 1)) attn_phase(F, ws, l, l + 2 * REP, (REP == 1 && REPEAT_SUB >= 3) ? REPEAT_SUB : 0);
            if (REP == 0 && F.G == 256 && F.bx >= 96) { __syncthreads(); cvt_fill(F, CV_I_EXP - N_DEFER + N_DEF1A + N_DEF1 + N_DEF3 + l * N_DEF2 + ((F.bx - 96) * NWAVES + F.wave) * N_FILL2, N_FILL2); }
            PHASE_END(pb + 1);
        }
        if (IN(pb + 2)) {
            PHASE_ENV();
            const int hh = lane >> 5, d4 = (lane & 31) * 4;
            auto comb = [&](float l0, float l1, float l2, u32x2 a, u32x2 b_, u32x2 c, int it) {
                const float mx = fmaxf(l0, fmaxf(l1, l2)); const float e0 = __builtin_amdgcn_exp2f(l0 - mx), e1 = __builtin_amdgcn_exp2f(l1 - mx), e2 = __builtin_amdgcn_exp2f(l2 - mx); const float inv = 1.f / (e0 + e1 + e2);
                const float w0 = e0 * inv, w1 = e1 * inv, w2 = e2 * inv;
                u32x2 o; o.x = pk2(w0 * bf_lo(a.x) + w1 * bf_lo(b_.x) + w2 * bf_lo(c.x), w0 * bf_hi(a.x) + w1 * bf_hi(b_.x) + w2 * bf_hi(c.x));
                o.y = pk2(w0 * bf_lo(a.y) + w1 * bf_lo(b_.y) + w2 * bf_lo(c.y), w0 * bf_hi(a.y) + w1 * bf_hi(b_.y) + w2 * bf_hi(c.y));
                *(u32x2*)((bf16_t*)(ws + WS_YC) + (size_t)it * 256 + hh * 128 + d4) = o; };
            if (4 * NGW == T) {
                float ll[4][3]; u32x2 q[4][3];
#pragma unroll
                for (int k = 0; k < 4; ++k) { const int it = gw + k * NGW; const float* ls = (const float*)(ws + WS_LSE) + (size_t)it * 6 + hh; ll[k][0] = ls[0]; ll[k][1] = ls[2]; ll[k][2] = ls[4];
                    const bf16_t* od = (const bf16_t*)(ws + WS_OD) + ((size_t)it * 6 + hh) * 128 + d4; q[k][0] = *(const u32x2*)od; q[k][1] = *(const u32x2*)(od + 256); q[k][2] = *(const u32x2*)(od + 512); }
#pragma unroll
                for (int k = 0; k < 4; ++k) comb(ll[k][0], ll[k][1], ll[k][2], q[k][0], q[k][1], q[k][2], gw + k * NGW);
            } else
            for (int it = gw; it < T; it += NGW) {
                const float* ls = (const float*)(ws + WS_LSE) + (size_t)it * 6 + hh; const float l0 = ls[0], l1 = ls[2], l2 = ls[4];
                const bf16_t* od = (const bf16_t*)(ws + WS_OD) + ((size_t)it * 6 + hh) * 128 + d4;
                const u32x2 a = *(const u32x2*)od, b_ = *(const u32x2*)(od + 256), c = *(const u32x2*)(od + 512);
                comb(l0, l1, l2, a, b_, c, it);
            }
            PHASE_END(pb + 2);
        }
        if (IN(pb + 3)) {
            PHASE_ENV();
            SchedP3 S; S.G = F.G; S.c = F.bx; S.l = l; S.ws = ws;
            EpiBranch E; E.G = (const char*)(ws + WS_G); E.PB = (char*)(ws + WS_MP); E.MG = (bf16_t*)(ws + WS_MG);
            { const UnitTab UT_ = build_units(F.lds, S); g8::gemm_phase<EpiBranch, UnitTab>(F.lds, UT_, E); }
            PHASE_END(pb + 3);
        }
        if (IN(pb + 4)) {
            PHASE_ENV();
            SchedSimple S; S.G = F.G; S.c = F.bx; S.A = (const char*)(ws + WS_MG); S.B = (const char*)(ws + WS_WO) + (size_t)l * D * D * 2; S.lda2 = 4096; S.ldb2 = 4096; S.nM = 32; S.nN = 8; S.nt = 32; S.colmul = 256;
            EpiResid E; E.Xin = (l == 0) ? ((const float*)(GAS const float*)ka->in[0]) : (const float*)(ws + WS_X); E.Xout = (float*)(ws + WS_X); E.ldc = D;
            { const UnitTab UT_ = build_units(F.lds, S); g8::gemm_phase<EpiResid, UnitTab>(F.lds, UT_, E); }
            PHASE_END(pb + 4);
        }
}
__device__ __forceinline__ void dense_ffn_phases(Frame& F, const XcdBarrier& bar, const int lo, const int hi) {
            if (IN(6)) { PHASE_ENV(); const float* gain = ((const float*)(GAS const float*)ka->in[14]); for (int it = gw; it < T; it += NGW) rms_row_bf16((const float*)(ws + WS_X) + (size_t)it * D, gain, (bf16_t*)(ws + WS_H) + (size_t)it * D, lane); PHASE_END(6); }
            if (IN(7)) {
                PHASE_ENV();
                SchedSimple S; S.G = F.G; S.c = F.bx; S.A = (const char*)(ws + WS_H); S.B = (const char*)(ws + WS_DGU); S.lda2 = 4096; S.ldb2 = 4096; S.nM = 32; S.nN = 44; S.nt = 32; S.colmul = 128;
                EpiSwigluT<false> E; S.O = (char*)(ws + WS_ACT);
                { const UnitTab UT_ = build_units(F.lds, S); g8::gemm_phase<EpiSwigluT<false>, UnitTab>(F.lds, UT_, E); }
                if (F.G == 256 && F.bx >= FILL3_BLK0) cvt_fill(F, CV_I_EXP - N_DEFER + N_DEF1A + N_DEF1 + ((F.bx - FILL3_BLK0) * NWAVES + F.wave) * N_FILL);
                PHASE_END(7);
            }
            if (IN(8)) {
                PHASE_ENV();
                SchedSimple S; S.G = F.G; S.c = F.bx; S.A = (const char*)(ws + WS_ACT); S.B = (const char*)(ws + WS_DD); S.lda2 = F8_DFD ? DFF : DFF * 2; S.ldb2 = S.lda2; S.nM = 32; S.nN = 8; S.nt = F8_DFD ? DFF / 128 : DFF / 64; S.colmul = 256;
                EpiResidT<(F8_DFD != 0)> E; E.Xin = (const float*)(ws + WS_X); E.Xout = (float*)(ws + WS_X); E.ldc = D;
                { const UnitTab UT_ = build_units(F.lds, S); g8::gemm_phase<EpiResidT<(F8_DFD != 0)>, UnitTab, (F8_DFD != 0)>(F.lds, UT_, E); }
                PHASE_END(8);
            }
            if (IN(9)) { PHASE_ENV(); const float* gain = ((const float*)(GAS const float*)ka->in[2]) + D; for (int it = gw; it < T; it += NGW) { if (F8_P1) rms_row_f8((const float*)(ws + WS_X) + (size_t)it * D, gain, (unsigned char*)(ws + WS_H) + (size_t)it * D, lane); else rms_row_bf16((const float*)(ws + WS_X) + (size_t)it * D, gain, (bf16_t*)(ws + WS_H) + (size_t)it * D, lane); } PHASE_END(9); }
}
__device__ __forceinline__ void moe_ffn_phases(Frame& F, const XcdBarrier& bar, const int lo, const int hi) {
            if (IN(15)) {
                PHASE_ENV();
                const float* rt = ((const float*)(GAS const float*)ka->in[18]); const float* gain = ((const float*)(GAS const float*)ka->in[14]) + D;
                LAS float* Rt = (LAS float*)(F.lds + 4096);
                for (int k = F.tid; k < D; k += NTHREADS) { const f32x4 r0 = ((const f32x4*)rt)[2 * k], r1 = ((const f32x4*)rt)[2 * k + 1];
                    Rt[0 * D + k] = r0.x; Rt[1 * D + k] = r0.y; Rt[2 * D + k] = r0.z; Rt[3 * D + k] = r0.w; Rt[4 * D + k] = r1.x; Rt[5 * D + k] = r1.y; Rt[6 * D + k] = r1.z; Rt[7 * D + k] = r1.w; }
                __syncthreads();
                for (int it = gw; it < T; it += NGW) {
                    const f32x4* xr = (const f32x4*)((const float*)(ws + WS_X) + (size_t)it * D) + lane; const f32x4* gr = (const f32x4*)gain + lane;
                    f32x4 v[8]; float s = 0.f;
#pragma unroll
                    for (int j = 0; j < 8; ++j) { v[j] = xr[64 * j]; s += (v[j].x * v[j].x + v[j].y * v[j].y) + (v[j].z * v[j].z + v[j].w * v[j].w); }
                    const float rstd = __builtin_amdgcn_rsqf(wave_sum(s) * (1.f / D) + RMS_EPS);
                    float lg[8];
#pragma unroll
                    for (int e = 0; e < 8; ++e) lg[e] = 0.f;
                    unsigned* o8 = (unsigned*)((unsigned char*)(ws + WS_H) + (size_t)it * D) + lane;
                    u32x2* o16 = (u32x2*)((bf16_t*)(ws + WS_H) + (size_t)it * D) + lane;
#pragma unroll
                    for (int j = 0; j < 8; ++j) { const f32x4 g = gr[64 * j]; v[j].x *= rstd * g.x; v[j].y *= rstd * g.y; v[j].z *= rstd * g.z; v[j].w *= rstd * g.w;
                        if (F8_GU) { const float q = (float)(1 << F8S_H); o8[64 * j] = pk4f8(v[j].x * q, v[j].y * q, v[j].z * q, v[j].w * q); }
                        else { u32x2 w; w.x = pk2(v[j].x, v[j].y); w.y = pk2(v[j].z, v[j].w); o16[64 * j] = w; } }
#pragma unroll
                    for (int j = 0; j < 8; ++j) { const f32x4 hv = v[j];
                        asm volatile("" ::: "memory");
#pragma unroll
                        for (int e = 0; e < 8; ++e) { const f32x4 r = *(const LAS f32x4*)(Rt + e * D + 4 * (lane + 64 * j));
                            lg[e] += hv.x * r.x; lg[e] += hv.y * r.y; lg[e] += hv.z * r.z; lg[e] += hv.w * r.w; } }
#pragma unroll
                    for (int e = 0; e < 8; ++e) lg[e] = wave_sum(lg[e]);
                    if (lane == 0) {
                        int e1 = 0; float v1 = lg[0];
#pragma unroll
                        for (int e = 1; e < 8; ++e) if (lg[e] > v1) { v1 = lg[e]; e1 = e; }
                        int e2 = -1; float v2 = -3.0e38f;
#pragma unroll
                        for (int e = 0; e < 8; ++e) if (e != e1 && lg[e] > v2) { v2 = lg[e]; e2 = e; }
                        const float p2 = __expf(v2 - v1), w1 = 1.f / (1.f + p2), w2 = p2 / (1.f + p2);
                        ((int*)(ws + WS_TOKE))[2 * it] = e1; ((int*)(ws + WS_TOKE))[2 * it + 1] = e2;
                        { const int li = (((it - gw) / NGW) * NWAVES + F.wave) * 2; LAS int* el = (LAS int*)(F.lds); if (li < 64) { el[li] = e1; el[li + 1] = e2; } }
                        ((float*)(ws + WS_TOKW))[2 * it] = w1; ((float*)(ws + WS_TOKW))[2 * it + 1] = w2;
                    }
                }
                if (F.G == 256) {
                    __syncthreads();
                    LAS int* el = (LAS int*)(F.lds); const int t = F.tid;
                    if (t < 64) { const int e = el[t]; int lr = 0;
                        for (int j = 0; j < 64; ++j) lr += (j < t && el[j] == e) ? 1 : 0;
                        const int k = t >> 4, w = (t >> 1) & 7, kk = t & 1, tok = (F.bx * NWAVES + w) + k * NGW;
                        ((int*)(ws + WS_RANK))[2 * tok + kk] = lr; }
                    else if (t < 72) { const int e = t - 64; int c = 0;
                        for (int j = 0; j < 64; ++j) c += (el[j] == e) ? 1 : 0;
                        ((int*)(ws + WS_CTL))[CW_HIST + F.bx * 8 + e] = c; }
                }
                PHASE_END(15);
            }
            if (IN(16)) {
                PHASE_ENV();
                if (F.G != 256 && F.bx < 8) {
                    const int e = F.bx; const int* te = (const int*)(ws + WS_TOKE); int* rk = (int*)(ws + WS_RANK);
                    LAS int* wsum = (LAS int*)(F.lds);
                    int base = 0;
                    for (int c0 = 0; c0 < 2 * T; c0 += NTHREADS) {
                        const int idx = c0 + F.tid; const bool hit = te[idx] == e;
                        const unsigned long long bal = __ballot(hit);
                        const int pre = __popcll(bal & ((1ull << lane) - 1ull)), tot = __popcll(bal);
                        __syncthreads();
                        if (lane == 0) wsum[F.wave] = tot;
                        __syncthreads();
                        int woff = 0, all = 0;
#pragma unroll
                        for (int w = 0; w < 8; ++w) { const int t = wsum[w]; if (w < F.wave) woff += t; all += t; }
                        if (hit) rk[idx] = base + woff + pre;
                        base += all;
                    }
                    if (F.tid == 0) ((int*)(ws + WS_CTL))[CW_MOE + e] = base;
                }
                if (BOTH(16) && F.G != 256) { GRID_BAR(); }
            }
            if (IN(17)) {
                PHASE_ENV();
                const bool fast = F.G == 256;
                LAS int* H = (LAS int*)(F.lds); LAS int* tot = H + 2048;
                if (fast) {
                    ((LAS i32x4*)H)[F.tid] = ((const i32x4*)((const int*)(ws + WS_CTL) + CW_HIST))[F.tid];
                    __syncthreads();
                    { const int e = F.wave; int v[4], sm = 0;
#pragma unroll
                      for (int j = 0; j < 4; ++j) { v[j] = H[(4 * lane + j) * 8 + e]; sm += v[j]; }
                      int incl = sm;
#pragma unroll
                      for (int o = 1; o < 64; o <<= 1) { const int u_ = __shfl_up(incl, o); if (lane >= o) incl += u_; }
                      int ex = incl - sm;
#pragma unroll
                      for (int j = 0; j < 4; ++j) { H[(4 * lane + j) * 8 + e] = ex; ex += v[j]; }
                      if (lane == 63) tot[e] = incl; }
                    __syncthreads();
                    if (F.bx == 0 && F.tid < 8) ((int*)(ws + WS_CTL))[CW_MOE + F.tid] = tot[F.tid];
                }
                int off[8]; { int a = 0;
#pragma unroll
                    for (int e = 0; e < 8; ++e) { off[e] = a; a += fast ? tot[e] : ((const int*)(ws + WS_CTL))[CW_MOE + e]; } }
                for (int it = gw; it < 2 * T; it += NGW) {
                    const int e = ((const int*)(ws + WS_TOKE))[it], rk = ((const int*)(ws + WS_RANK))[it];
                    int o = 0;
#pragma unroll
                    for (int q = 0; q < 8; ++q) o = (e == q) ? off[q] : o;
                    const int slot = o + rk + (fast ? H[((((it >> 1) & (NGW - 1)) >> 3) * 8) + e] : 0);
                    if (lane == 0) ((int*)(ws + WS_TOKS))[it] = slot;
                    constexpr int RB = F8_GU ? D : 2 * D;
                    const u32x4* src = (const u32x4*)((const unsigned char*)(ws + WS_H) + (size_t)(it >> 1) * RB) + lane; u32x4* dst = (u32x4*)((unsigned char*)(ws + WS_HA) + (size_t)slot * RB) + lane;
#pragma unroll
                    for (int j = 0; j < RB / 1024; ++j) dst[64 * j] = src[64 * j];
                }
                PHASE_END(17);
            }
            if (IN(18)) {
                PHASE_ENV();
                SchedMoe S; S.G = F.G; S.c = F.bx; S.A = (const char*)(ws + WS_HA); S.B = (const char*)(ws + WS_EGU); S.lda2 = F8_GU ? 2048 : 4096; S.ldb2 = S.lda2; S.wstride = (size_t)14336 * S.lda2; S.nN = 56; S.nt = F8_GU ? 16 : 32; S.colmul = 128;
                S.cntp = (const int*)(ws + WS_CTL) + CW_MOE;
                EpiSwigluT<true> E; S.O = (char*)(ws + WS_EACT);
                { const UnitTab UT_ = build_units(F.lds, S); g8::gemm_phase<EpiSwigluT<true>, UnitTab, (F8_GU != 0)>(F.lds, UT_, E); }
                PHASE_END(18);
            }
            if (IN(19)) {
                PHASE_ENV();
                SchedMoeDown S; S.G = F.G; S.c = F.bx; S.A = (const char*)(ws + WS_EACT); S.B = (const char*)(ws + WS_ED); S.lda2 = F8_DN ? EFF : 2 * EFF; S.ldb2 = S.lda2; S.wstride = (size_t)D * S.lda2; S.ntu = F8_DN ? EFF / 128 : EFF / 64;
                S.cntp = (const int*)(ws + WS_CTL) + CW_MOE; S.O0 = (char*)(ws + WS_OS); S.PB = (char*)(ws + WS_OS1);
                EpiMoeDown E;
                { const UnitTab UT_ = build_units(F.lds, S); g8::gemm_phase<EpiMoeDown, UnitTab, (F8_DN != 0)>(F.lds, UT_, E); }
                PHASE_END(19);
            }
            if (IN(20)) {
                PHASE_ENV();
                const float* fgain = ((const float*)(GAS const float*)ka->in[22]); float* outp = (float*)(GAS float*)ka->out;
                MoeDownPlan P; moe_down_plan((const int*)(ws + WS_CTL) + CW_MOE, F.G, P);
                const int split_start = __builtin_amdgcn_readfirstlane(P.split_start), S_ = __builtin_amdgcn_readfirstlane(P.S), trows = __builtin_amdgcn_readfirstlane(P.trows);
                auto tokrow = [&](const int it, const int sl0, const int sl1, const float w0, const float w1) {
                    const f32x4* xr = (const f32x4*)((const float*)(ws + WS_X) + (size_t)it * D) + lane;
                    const f32x4* gr = (const f32x4*)fgain + lane;
                    f32x4 v[8];
#pragma unroll
                    for (int j = 0; j < 8; ++j) v[j] = xr[64 * j];
#pragma unroll
                    for (int k = 0; k < 2; ++k) {
                        const int sl = k == 0 ? sl0 : sl1; const float w = k == 0 ? w0 : w1;
                        if (sl < split_start) { const u32x2* o = (const u32x2*)((const bf16_t*)(ws + WS_OS) + (size_t)sl * D) + lane;
#pragma unroll
                            for (int j = 0; j < 8; ++j) { const u32x2 q = o[64 * j]; v[j].x += w * bf_lo(q.x); v[j].y += w * bf_hi(q.x); v[j].z += w * bf_lo(q.y); v[j].w += w * bf_hi(q.y); } }
                        else for (int p_ = 0; p_ < S_; ++p_) { const f32x4* o = (const f32x4*)((const float*)(ws + WS_OS1) + ((size_t)p_ * trows + (sl - split_start)) * D) + lane;
#pragma unroll
                            for (int j = 0; j < 8; ++j) v[j] += w * o[64 * j]; }
                    }
                    float s = 0.f;
#pragma unroll
                    for (int j = 0; j < 8; ++j) s += (v[j].x * v[j].x + v[j].y * v[j].y) + (v[j].z * v[j].z + v[j].w * v[j].w);
                    const float rstd = __builtin_amdgcn_rsqf(wave_sum(s) * (1.f / D) + RMS_EPS);
                    f32x4* orow = (f32x4*)(outp + (size_t)it * D) + lane;
#pragma unroll
                    for (int j = 0; j < 8; ++j) { const f32x4 g = gr[64 * j]; orow[64 * j] = v[j] * rstd * g; }
                };
                const int* tks = (const int*)(ws + WS_TOKS); const float* tkw = (const float*)(ws + WS_TOKW);
                if (4 * NGW == T) {
                    int sq[8]; float wq[8];
#pragma unroll
                    for (int k = 0; k < 4; ++k) { const int it = gw + k * NGW; sq[2 * k] = __builtin_amdgcn_readfirstlane(tks[2 * it]); sq[2 * k + 1] = __builtin_amdgcn_readfirstlane(tks[2 * it + 1]);
                        wq[2 * k] = __uint_as_float(__builtin_amdgcn_readfirstlane(__float_as_uint(tkw[2 * it]))); wq[2 * k + 1] = __uint_as_float(__builtin_amdgcn_readfirstlane(__float_as_uint(tkw[2 * it + 1]))); }
#pragma unroll
                    for (int k = 0; k < 4; ++k) tokrow(gw + k * NGW, sq[2 * k], sq[2 * k + 1], wq[2 * k], wq[2 * k + 1]);
                } else
                for (int it = gw; it < T; it += NGW) tokrow(it, __builtin_amdgcn_readfirstlane(tks[2 * it]), __builtin_amdgcn_readfirstlane(tks[2 * it + 1]), tkw[2 * it], tkw[2 * it + 1]);
            }
}
__global__ void __launch_bounds__(NTHREADS, 2) fwd_kernel(Args args) {
    extern __shared__ __attribute__((aligned(16))) unsigned char lds_raw[];
    Frame F;
    F.lds = (LAS unsigned char*)lds_raw; F.MISC = (volatile LAS unsigned*)(F.lds + MISC_OFF);
    F.tid = threadIdx.x; F.lane = F.tid & 63; F.wave = __builtin_amdgcn_readfirstlane(F.tid >> 6); F.G = gridDim.x; F.bx = blockIdx.x;
    if (F.tid < 64) ((LAS unsigned*)(F.lds + MISC_OFF))[F.tid] = 0u;
    __syncthreads();
    XcdBarrier bar; bar.bar = (unsigned*)(GAS unsigned*)(args.ws + WS_CTL) + CW_BAR; bar.x = 0; bar.st = nullptr;
    if (N_LAUNCHES == 1) bar = xcd_barrier_post((unsigned*)(GAS unsigned*)(args.ws + WS_CTL) + CW_BAR, F.MISC + 8);
    const int lo = args.ph_lo, hi = args.ph_hi;

    STAMP(0);

#ifndef REPEAT_PHASE
#define REPEAT_PHASE -1
#endif
    if (REPEAT_PHASE == 0 && N_LAUNCHES == 1) { p0_prologue(F); GRID_BAR(); }
    if (IN(0)) { p0_prologue(F); PHASE_END(0); }
    if (REPEAT_PHASE >= 1 && REPEAT_PHASE <= 4 && N_LAUNCHES == 1) { mixer_phases<0, 1>(F, bar, REPEAT_PHASE, REPEAT_PHASE + 1); GRID_BAR(); }
    mixer_phases<0, 0>(F, bar, lo, hi);
    if (REPEAT_PHASE == 7 && N_LAUNCHES == 1) { dense_ffn_phases(F, bar, 7, 8); GRID_BAR(); }
    dense_ffn_phases(F, bar, lo, hi);
    if (REPEAT_PHASE >= 1 && REPEAT_PHASE <= 4 && N_LAUNCHES == 1) { mixer_phases<1, 1>(F, bar, REPEAT_PHASE + 9, REPEAT_PHASE + 10); GRID_BAR(); }
    mixer_phases<1, 0>(F, bar, lo, hi);
    moe_ffn_phases(F, bar, lo, hi);
    if (REPEAT_PHASE >= 15 && REPEAT_PHASE <= 19 && N_LAUNCHES == 1) { GRID_BAR(); moe_ffn_phases(F, bar, REPEAT_PHASE, REPEAT_PHASE + 1); }
#if defined(PROBE_A)
    GRID_BAR(); STAMP(NPHASE);
    GRID_BAR();
    { KArgsPtr ka = kargs(); const volatile unsigned long long* st = (const volatile unsigned long long*)((unsigned*)(GAS unsigned*)(ka->ws + WS_CTL) + CW_STAMP);
      const float ta = (float)(st[PROBE_A + 1] - st[PROBE_A]) * 0.01f, tb = (float)(st[PROBE_B + 1] - st[PROBE_B]) * 0.01f;
      float* o = (float*)(GAS float*)ka->out; const float v1 = sqrtf(ta * 0.1f);
      int t_ = F.tid; asm volatile("" : "+v"(t_));
      for (size_t i = (size_t)F.bx * NTHREADS + t_; i < (size_t)T * D; i += (size_t)F.G * NTHREADS) o[i] = (i == 12345) ? tb : v1; }
#endif
}
#undef IN
#undef BOTH
#undef GRID_BAR
#undef PHASE_ENV

extern "C" void kernel_launch(void* const* d_in, const int* in_sizes, int n_in, void* d_out, int out_size, void* d_ws, size_t ws_size, hipStream_t stream) {
    static int grid = 0;
    if (grid == 0) {
        if (n_in != 23 || out_size != T * D || ws_size < WS_END) { fprintf(stderr, "kernel_launch: unexpected shapes (n_in %d out %d ws %zu need %zu)\n", n_in, out_size, ws_size, (size_t)WS_END); grid = -1; return; }
        int dev = 0, cus = 0, per_cu = 0;
        if (hipGetDevice(&dev) != hipSuccess || hipDeviceGetAttribute(&cus, hipDeviceAttributeMultiprocessorCount, dev) != hipSuccess) { grid = -1; return; }
        if (hipFuncSetAttribute((const void*)fwd_kernel, hipFuncAttributeMaxDynamicSharedMemorySize, LDS_BYTES) != hipSuccess) { fprintf(stderr, "kernel_launch: hipFuncSetAttribute failed\n"); grid = -1; return; }
        if (hipOccupancyMaxActiveBlocksPerMultiprocessor(&per_cu, (const void*)fwd_kernel, NTHREADS, LDS_BYTES) != hipSuccess || per_cu < 1) { fprintf(stderr, "kernel_launch: occupancy query says %d\n", per_cu); (void)hipGetLastError(); grid = -1; return; }
        grid = cus;
    }
    if (grid < 0) return;
    if (hipMemsetAsync((char*)d_ws + WS_CTL, 0, CTL_ZERO_BYTES, stream) != hipSuccess) return;
    Args a{};
    for (int i = 0; i < 23; ++i) a.in[i] = (const float*)d_in[i];
    a.out = (float*)d_out; a.ws = (unsigned char*)d_ws;
    if (N_LAUNCHES == 1) { a.ph_lo = 0; a.ph_hi = NPHASE; hipLaunchKernelGGL(fwd_kernel, dim3(grid), dim3(NTHREADS), LDS_BYTES, stream, a); }
    else for (int p = 0; p < NPHASE; ++p) { a.ph_lo = p; a.ph_hi = p + 1; hipLaunchKernelGGL(fwd_kernel, dim3(grid), dim3(NTHREADS), LDS_BYTES, stream, a); }
}
```

```cpp
#include <hip/hip_runtime.h>
#include <cstdio>
#include <cstdint>

#ifndef N_LAUNCHES
#define N_LAUNCHES 1
#endif

#define LAS __attribute__((address_space(3)))
#define GAS __attribute__((address_space(1)))
#define AS_GLOBAL(T, p) ((T)(GAS T)(p))
typedef unsigned short bf16_t;
typedef short bf16x8 __attribute__((ext_vector_type(8)));
typedef short s16x4 __attribute__((ext_vector_type(4)));
typedef float f32x2 __attribute__((ext_vector_type(2)));
typedef float f32x4 __attribute__((ext_vector_type(4)));
typedef float f32x16 __attribute__((ext_vector_type(16)));
typedef unsigned u32x2 __attribute__((ext_vector_type(2)));
typedef unsigned u32x4 __attribute__((ext_vector_type(4)));
typedef int i32x4 __attribute__((ext_vector_type(4)));
typedef __bf16 nbf16x2 __attribute__((ext_vector_type(2)));

__device__ __forceinline__ unsigned pk2(float a, float b) { f32x2 v = {a, b}; nbf16x2 r = __builtin_convertvector(v, nbf16x2); return __builtin_bit_cast(unsigned, r); }
__device__ __forceinline__ unsigned pk4f8(float a, float b, float c, float d) {
    a = __builtin_amdgcn_fmed3f(a, -448.f, 448.f); b = __builtin_amdgcn_fmed3f(b, -448.f, 448.f); c = __builtin_amdgcn_fmed3f(c, -448.f, 448.f); d = __builtin_amdgcn_fmed3f(d, -448.f, 448.f);
    int w = 0; w = __builtin_amdgcn_cvt_pk_fp8_f32(a, b, w, false); w = __builtin_amdgcn_cvt_pk_fp8_f32(c, d, w, true); return (unsigned)w; }
__device__ __forceinline__ float bf_lo(unsigned w) { return __uint_as_float(w << 16); }
__device__ __forceinline__ float bf_hi(unsigned w) { return __uint_as_float(w & 0xffff0000u); }
#define LDS_WAIT() asm volatile("s_waitcnt lgkmcnt(0)" ::: "memory")
#define VM_WAIT() asm volatile("s_waitcnt vmcnt(0)" ::: "memory")

constexpr int T = 8192, D = 2048, SEQ = 2048, NB = 4, MEML = 256;
constexpr int DFF = 5632, EFF = 7168, NEXP = 8;
constexpr int ZC = 3840;
constexpr int SWR = 3072;
constexpr float RMS_EPS = 1e-6f;
constexpr int F8S_WGU = 10, F8S_WD = 11, F8S_H = 4, F8S_ACT = 3;
#ifndef F8_GU
#define F8_GU 1
#endif
#ifndef F8_P1
#define F8_P1 1
#endif
#ifndef F8_G0
#define F8_G0 1
#endif
#ifndef F8_Z0
#define F8_Z0 1
#endif
#ifndef F8_DFD
#define F8_DFD 0
#endif
#ifndef F8_DN
#define F8_DN 1
#endif
constexpr int NWAVES = 8, NTHREADS = 512;

constexpr size_t MiB = 1u << 20;
constexpr size_t WS_CTL = 0, CTL_ZERO_BYTES = 1 * MiB;
constexpr size_t WS_TAB = 1 * MiB;
constexpr size_t WS_TOKE = WS_TAB + 256 * 1024;
constexpr size_t WS_TOKW = WS_TOKE + 64 * 1024;
constexpr size_t WS_TOKS = WS_TOKW + 64 * 1024;
constexpr size_t WS_RANK = WS_TOKS + 64 * 1024;
constexpr size_t WS_DFT = 2 * MiB;
constexpr size_t WS_X = 18 * MiB;
constexpr size_t WS_H = 82 * MiB;
constexpr size_t WS_MEMN = 114 * MiB;
constexpr size_t WS_WIN = 122 * MiB;
constexpr size_t WS_WS = 152 * MiB;
constexpr size_t WS_WG = 176 * MiB;
constexpr size_t WS_WMEM = 240 * MiB;
constexpr size_t WS_WBR = 252 * MiB;
constexpr size_t WS_WO = 272 * MiB;
constexpr size_t WS_DGU = 288 * MiB;
constexpr size_t WS_DD = 332 * MiB;
constexpr size_t WS_EGU = 354 * MiB;
constexpr size_t WS_ED = 802 * MiB;
constexpr size_t WS_Z = 1026 * MiB;
constexpr size_t WS_VT = 1086 * MiB;
constexpr size_t WS_UT = 1110 * MiB;
constexpr size_t WS_G = 1134 * MiB;
constexpr size_t WS_KM = 1262 * MiB;
constexpr size_t WS_VMT = 1264 * MiB;
constexpr size_t WS_YA = 1266 * MiB, WS_YB = 1278 * MiB, WS_YC = 1290 * MiB, WS_YM = 1294 * MiB;
constexpr size_t WS_MP = 1306 * MiB;
constexpr size_t WS_OD = 1338 * MiB;
constexpr size_t WS_LSE = 1350 * MiB;
constexpr size_t WS_MG = 1370 * MiB;
constexpr size_t WS_ACT = 1402 * MiB;
constexpr size_t WS_H8 = 1402 * MiB;
constexpr size_t WS_HA = 1026 * MiB;
constexpr size_t WS_EACT = 1091 * MiB;
constexpr size_t WS_OS = 1319 * MiB;
constexpr size_t WS_OS1 = 1447 * MiB;
constexpr size_t WS_END = 1575 * MiB;
static_assert(WS_HA + (size_t)16640 * 2048 * 2 <= WS_EACT && WS_EACT + (size_t)16640 * 7168 * 2 <= WS_OS && WS_OS + (size_t)16384 * 2048 * 4 <= WS_END, "moe map");

constexpr int CW_TMO = 0, CW_CODE = 1;
constexpr int CW_BAR = 4096;
constexpr int CW_Q = 8192;
constexpr int CW_MOE = 15360;
constexpr int CW_HIST = 16384;

constexpr int RING_BYTES = 131072;
constexpr int XTAB_OFF = RING_BYTES;
constexpr int MISC_OFF = XTAB_OFF + 11264;
constexpr int UTAB_OFF = MISC_OFF + 256;
constexpr int LDS_BYTES = 147456;
static_assert(UTAB_OFF + 2048 <= LDS_BYTES, "lds");

#define XB_TMO      128
#define XB_XCNT(j)  (256  + 64 * (j))
#define XB_XSUB(j)  (1280 + 64 * (j))
#define XB_XGEN(j)  (2304 + 64 * (j))
#define XB_TOP      3328
#define XB_TOPGEN   3392
#define XCD_BAR_WORDS 3456
#define XB_SPIN_CAP (1u << 18)
__device__ __forceinline__ unsigned xb_ld(unsigned* p)              { return __hip_atomic_load(p, __ATOMIC_RELAXED, __HIP_MEMORY_SCOPE_AGENT); }
__device__ __forceinline__ unsigned xb_add(unsigned* p, unsigned v) { return __hip_atomic_fetch_add(p, v, __ATOMIC_RELAXED, __HIP_MEMORY_SCOPE_AGENT); }
__device__ __forceinline__ unsigned xb_xcc_id() { return (unsigned)__builtin_amdgcn_s_getreg((3 << 11) | 20) & 0xFu; }
#define XB_SPIN(cond, bar) do { unsigned _sp = 0; while (cond) { __builtin_amdgcn_s_sleep(1); \
    if ((++_sp & 255u) == 0u) { if (xb_ld(&(bar)[XB_TMO])) break; if (_sp > XB_SPIN_CAP) { atomicAdd(&(bar)[XB_TMO], 1u); break; } } } } while (0)
struct XcdBarrier { unsigned* bar; unsigned x; volatile LAS unsigned* st; };
__device__ __forceinline__ XcdBarrier xcd_barrier_post(unsigned* bar, volatile LAS unsigned* st) {
    XcdBarrier b; b.bar = bar; b.x = xb_xcc_id(); b.st = st;
    if (threadIdx.x == 0) (void)xb_add(&bar[XB_XCNT(b.x)], 1u);
    return b;
}
__device__ __forceinline__ void xcd_barrier_complete(unsigned* bar, unsigned x, unsigned& nloc, unsigned& nx) {
    const unsigned G = gridDim.x * gridDim.y * gridDim.z;
    unsigned sum, cnt, mine, sp = 0u;
    for (;;) {
        sum = 0u; cnt = 0u; mine = 0u;
#pragma unroll
        for (unsigned j = 0; j < 16; ++j) { const unsigned c = xb_ld(&bar[XB_XCNT(j)]); sum += c; cnt += (c > 0u) ? 1u : 0u; mine = (j == x) ? c : mine; }
        if (sum == G) break;
        __builtin_amdgcn_s_sleep(1);
        if ((++sp & 255u) == 0u) { if (xb_ld(&bar[XB_TMO])) break; if (sp > XB_SPIN_CAP) { atomicAdd(&bar[XB_TMO], 1u); break; } }
    }
    nloc = mine > 0u ? mine : 1u; nx = cnt > 0u ? cnt : 1u;
}
__device__ __forceinline__ void xcd_barrier(const XcdBarrier& b) {
    asm volatile("s_waitcnt vmcnt(0)" ::: "memory");
    __syncthreads();
    if (threadIdx.x == 0) {
        unsigned* bar = b.bar;
        __builtin_amdgcn_s_waitcnt(0);
        unsigned nloc = b.st[0], nx = b.st[1];
        if (nloc == 0u) { xcd_barrier_complete(bar, b.x, nloc, nx); b.st[0] = nloc; b.st[1] = nx; }
        const unsigned old = xb_add(&bar[XB_XSUB(b.x)], 1u);
        const unsigned gen = old / nloc;
        if (old + 1u == (gen + 1u) * nloc) {
            __builtin_amdgcn_fence(__ATOMIC_RELEASE, "agent");
            asm volatile("s_waitcnt vmcnt(0)" ::: "memory");
            const unsigned og = xb_add(&bar[XB_TOP], 1u);
            const unsigned tg = og / nx;
            if (og + 1u == (tg + 1u) * nx) xb_add(&bar[XB_TOPGEN], 1u);
            else XB_SPIN(xb_ld(&bar[XB_TOPGEN]) == tg, bar);
            __builtin_amdgcn_fence(__ATOMIC_ACQUIRE, "agent");
            xb_add(&bar[XB_XGEN(b.x)], 1u);
            asm volatile("s_waitcnt vmcnt(0)" ::: "memory");
        } else {
            XB_SPIN(xb_ld(&bar[XB_XGEN(b.x)]) == gen, bar);
            __builtin_amdgcn_fence(__ATOMIC_ACQUIRE, "agent");
            asm volatile("s_waitcnt vmcnt(0)" ::: "memory");
        }
    }
    __syncthreads();
}

namespace g8 {
constexpr int BM = 256, BK = 64, HALF = 128, HTB = HALF * BK * 2, STAGE_BYTES = 8 * HTB;
__host__ __device__ __forceinline__ int lds_byte(int r, int c) { const int st = (r >> 4) * 2 + (c >> 5), rr = r & 15, cc = c & 31, ob = rr * 64 + cc * 2; return st * 1024 + (ob ^ (((ob >> 9) & 1) << 5)); }
__host__ __device__ __forceinline__ void stage_rc(int b, int& R, int& C) { const int st = b / 1024, sb = b % 1024, swz = sb ^ (((sb >> 9) & 1) << 5); R = (st >> 1) * 16 + swz / 64; C = (st & 1) * 32 + (swz % 64) / 2; }
__host__ __device__ __forceinline__ int perm32(int rho) { const int n = rho >> 4, i = rho & 15; return 8 * (i >> 2) + 4 * n + (i & 3); }

struct Unit { const char* A; const char* B; char* O; unsigned lda2, ldb2; int ldc; int nt; int kind; int row0, col0, lim; };

__device__ __forceinline__ void tile_map(int L, int nM, int nN, int& pm, int& pn) {
    const int nwg = nM * nN; const int q = nwg / 8, r = nwg % 8, xcd = L % 8, off = L / 8;
    const int wgid = (xcd < r ? xcd * (q + 1) : r * (q + 1) + (xcd - r) * q) + off;
    const int nig = 8 * nN, gid = wgid / nig, fm = gid * 8, gsz = (nM - fm) < 8 ? (nM - fm) : 8;
    pm = fm + ((wgid % nig) % gsz); pn = (wgid % nig) / gsz;
}

__device__ __forceinline__ const char* uni_ptr(const char* p) { const unsigned long long v = (unsigned long long)p; const unsigned lo = (unsigned)__builtin_amdgcn_readfirstlane((int)(unsigned)v), hi = (unsigned)__builtin_amdgcn_readfirstlane((int)(unsigned)(v >> 32));
    return (const char*)(GAS const char*)(((unsigned long long)hi << 32) | lo); }
template <class Epi, class Sched, bool F8 = false>
__device__ __forceinline__ void gemm_phase(LAS unsigned char* lds, const Sched& S, const Epi& E) {
    int tid_ = threadIdx.x; asm volatile("" : "+v"(tid_));
    const int tid = tid_, wid = __builtin_amdgcn_readfirstlane(tid >> 6), lane = tid & 63, wr = wid >> 2, wc = wid & 3, fr = lane & 15, fq = lane >> 4;
    unsigned spk[2];
#pragma unroll
    for (int i = 0; i < 2; ++i) { int R, C; stage_rc(tid * 16 + i * 8192, R, C); const int Rb = Epi::PERM ? ((R & ~31) + perm32(R & 31)) : R; spk[i] = (unsigned)R | ((unsigned)Rb << 8) | ((unsigned)(C * 2) << 16); }
    const unsigned ldsw = (unsigned)wid * 1024u;
    const int aoff = lds_byte(wr * 64 + fr, fq * 8), boff = lds_byte(wc * 32 + fr, fq * 8);
#define PG8_SA(b, h) (((b) * 2 + (h)) * HTB)
#define PG8_SB(b, h) ((4 + (b) * 2 + (h)) * HTB)
#define PG8_STAGE(bufoff, gbase, voff) do { const char* _gb = uni_ptr((const char*)(gbase)); _Pragma("unroll") for (int _i = 0; _i < 2; ++_i) \
        __builtin_amdgcn_global_load_lds((const unsigned*)(_gb + (voff)[_i]), (LAS unsigned*)(lds + (bufoff) + ldsw + _i * 8192), 16, 0, 0); } while (0)
#define PG8_LDA(dst, b, h) do { _Pragma("unroll") for (int m = 0; m < 4; ++m) _Pragma("unroll") for (int k = 0; k < 2; ++k) dst[m][k] = *(const LAS bf16x8*)(lds + PG8_SA(b, h) + aoff + m * 2048 + k * 1024); } while (0)
#define PG8_LDB(dst, b, h) do { _Pragma("unroll") for (int n = 0; n < 2; ++n) _Pragma("unroll") for (int k = 0; k < 2; ++k) dst[n][k] = *(const LAS bf16x8*)(lds + PG8_SB(b, h) + boff + n * 2048 + k * 1024); } while (0)
#define PG8_CAT(x0, x1) __builtin_shufflevector(__builtin_bit_cast(i32x4, (x0)), __builtin_bit_cast(i32x4, (x1)), 0, 1, 2, 3, 4, 5, 6, 7)
#define PG8_MMA(ai, bj, At, Bt) do { __builtin_amdgcn_s_setprio(1); _Pragma("unroll") for (int m = 0; m < 4; ++m) _Pragma("unroll") for (int n = 0; n < 2; ++n) { \
        if constexpr (F8) acc[ai][bj][m][n] = __builtin_amdgcn_mfma_scale_f32_16x16x128_f8f6f4(PG8_CAT(Bt[n][0], Bt[n][1]), PG8_CAT(At[m][0], At[m][1]), acc[ai][bj][m][n], 0, 0, 0, 0, 0, 0); \
        else { _Pragma("unroll") for (int k = 0; k < 2; ++k) acc[ai][bj][m][n] = __builtin_amdgcn_mfma_f32_16x16x32_bf16(Bt[n][k], At[m][k], acc[ai][bj][m][n], 0, 0, 0); } } __builtin_amdgcn_s_setprio(0); } while (0)
#define PG8_WAIT_V(n) asm volatile("s_waitcnt vmcnt(" #n ")" ::: "memory")
#define PG8_WAIT_L(n) asm volatile("s_waitcnt lgkmcnt(" #n ")" ::: "memory")
#define PG8_BAR __builtin_amdgcn_s_barrier()
#define PG8_SCHED __builtin_amdgcn_sched_barrier(0)
#define PG8_SETV(u_) do { _Pragma("unroll") for (int _i = 0; _i < 2; ++_i) { vA[_i] = (spk[_i] & 255u) * (u_).lda2 + (spk[_i] >> 16); vB[_i] = ((spk[_i] >> 8) & 255u) * (u_).ldb2 + (spk[_i] >> 16); \
        asm volatile("" : "+v"(vA[_i]), "+v"(vB[_i])); } } while (0)
    int ui = 0, nt;
    const char *uA, *uB; unsigned hA, hB; unsigned vA[2], vB[2];
    { Unit u0; if (!S.next(0, u0)) return; uA = u0.A; uB = u0.B; hA = HALF * u0.lda2; hB = HALF * u0.ldb2; nt = u0.nt; PG8_SETV(u0); }
    f32x4 acc[2][2][4][2];
#pragma unroll
    for (int a = 0; a < 2; ++a)
#pragma unroll
        for (int b = 0; b < 2; ++b)
#pragma unroll
            for (int m = 0; m < 4; ++m)
#pragma unroll
                for (int n = 0; n < 2; ++n) acc[a][b][m][n] = (f32x4){0.f, 0.f, 0.f, 0.f};
    bf16x8 At[4][2], B0[2][2], B1[2][2];
    const size_t kstep = (size_t)(BK * 2);
    PG8_STAGE(PG8_SB(0, 0), uB, vB); PG8_STAGE(PG8_SB(0, 1), uB + hB, vB); PG8_STAGE(PG8_SA(0, 0), uA, vA); PG8_STAGE(PG8_SA(0, 1), uA + hA, vA);
    if (wr == 1) PG8_BAR;
    PG8_WAIT_V(2); PG8_BAR;
    PG8_STAGE(PG8_SB(1, 0), uB + kstep, vB); PG8_STAGE(PG8_SA(1, 0), uA + kstep, vA); PG8_STAGE(PG8_SB(1, 1), uB + hB + kstep, vB);
    PG8_WAIT_V(6); PG8_BAR;
    for (;;) {
        bool has_next = false; int nnt = nt;
        for (int t = 0; t < nt; t += 2) {
            const bool last = (t == nt - 2);
            PG8_LDB(B0, 0, 0); PG8_LDB(B1, 0, 1); PG8_SCHED; PG8_LDA(At, 0, 0); PG8_STAGE(PG8_SA(1, 1), uA + (size_t)(t + 1) * kstep + hA, vA);
            PG8_WAIT_V(8); PG8_WAIT_L(0); PG8_BAR; PG8_MMA(0, 0, At, B0); PG8_MMA(0, 1, At, B1); PG8_BAR; PG8_SCHED;
            const char *a2, *b2;
            if (last) { Unit nx; has_next = S.next(ui + 1, nx); if (has_next) { uA = nx.A; uB = nx.B; hA = HALF * nx.lda2; hB = HALF * nx.ldb2; nnt = nx.nt; PG8_SETV(nx); } a2 = uA; b2 = uB; }
            else { a2 = uA + (size_t)(t + 2) * kstep; b2 = uB + (size_t)(t + 2) * kstep; }
            const char* a3 = a2 + kstep; const char* b3 = b2 + kstep;
            PG8_LDA(At, 0, 1); PG8_STAGE(PG8_SB(0, 0), b2, vB); PG8_STAGE(PG8_SB(0, 1), b2 + hB, vB); PG8_STAGE(PG8_SA(0, 0), a2, vA);
            PG8_WAIT_V(8); PG8_WAIT_L(0); PG8_BAR; PG8_MMA(1, 0, At, B0); PG8_MMA(1, 1, At, B1); PG8_BAR; PG8_SCHED;
            PG8_LDB(B0, 1, 0); PG8_LDB(B1, 1, 1); PG8_SCHED; PG8_LDA(At, 1, 0); PG8_STAGE(PG8_SA(0, 1), a2 + hA, vA);
            PG8_WAIT_V(8); PG8_WAIT_L(0); PG8_BAR; PG8_MMA(0, 0, At, B0); PG8_MMA(0, 1, At, B1); PG8_BAR; PG8_SCHED;
            PG8_LDA(At, 1, 1); PG8_STAGE(PG8_SB(1, 0), b3, vB); PG8_STAGE(PG8_SB(1, 1), b3 + hB, vB); PG8_STAGE(PG8_SA(1, 0), a3, vA);
            PG8_WAIT_V(8); PG8_WAIT_L(0); PG8_BAR; PG8_MMA(1, 0, At, B0); PG8_MMA(1, 1, At, B1); PG8_BAR; PG8_SCHED;
        }
        if (wr == 0) PG8_BAR;
        { Unit eu; (void)S.next(ui, eu); int ln = lane; asm volatile("" : "+v"(ln));
          E(acc, eu, wr, wc, ln & 15, ln >> 4); }
        if (!has_next) break;
#pragma unroll
        for (int a = 0; a < 2; ++a)
#pragma unroll
            for (int b = 0; b < 2; ++b)
#pragma unroll
                for (int m = 0; m < 4; ++m)
#pragma unroll
                    for (int n = 0; n < 2; ++n) acc[a][b][m][n] = (f32x4){0.f, 0.f, 0.f, 0.f};
        ++ui; nt = nnt;
        if (wr == 1) PG8_BAR;
    }
    PG8_WAIT_V(0);
    PG8_BAR;
#undef PG8_SETV
#undef PG8_SA
#undef PG8_SB
#undef PG8_STAGE
#undef PG8_LDA
#undef PG8_LDB
#undef PG8_MMA
#undef PG8_CAT
#undef PG8_WAIT_V
#undef PG8_WAIT_L
#undef PG8_BAR
#undef PG8_SCHED
}
}
using g8::Unit;

enum { K_PLAIN = 0, K_ZROT = 1, K_GATE = 2, K_VTP4 = 3, K_VTP16 = 4 };

template <bool SC8> struct EpiP1T {
    static constexpr bool PERM = true;
    const float* bgate; const f32x2* rope;
    __device__ __forceinline__ void operator()(const f32x4 (&acc)[2][2][4][2], const Unit& u, int wr, int wc, int fr, int fq) const {
        const int kind = u.kind; const int ldc = u.ldc;
        bf16_t* O = (bf16_t*)u.O;
        const bool rot = (kind == K_ZROT) && (wc == 0);
#pragma unroll
        for (int ai = 0; ai < 2; ++ai)
#pragma unroll
            for (int m = 0; m < 4; ++m) {
                const int r = ai * 128 + wr * 64 + m * 16 + fr;
                bf16_t* rowp = O + (size_t)r * ldc + wc * 32 + 8 * fq;
                f32x4 cs0[2], cs1[2];
                if (rot) { const int pos = (u.row0 + r) & (SEQ - 1); const f32x4* rp = (const f32x4*)(rope + pos * 16 + 8 * (fq & 1)); cs0[0] = rp[0]; cs0[1] = rp[1]; cs1[0] = rp[2]; cs1[1] = rp[3]; }
#pragma unroll
                for (int bj = 0; bj < 2; ++bj) {
                    f32x4 v0 = acc[ai][bj][m][0], v1 = acc[ai][bj][m][1];
                    if constexpr (SC8) { v0 = v0 * (1.f / (float)(1 << (F8S_H + F8S_WGU))); v1 = v1 * (1.f / (float)(1 << (F8S_H + F8S_WGU))); }
                    if (kind == K_GATE) {
                        const float* bp = bgate + u.col0 + bj * 128 + wc * 32 + 8 * fq;
                        const f32x4 b0 = *(const f32x4*)bp, b1 = *(const f32x4*)(bp + 4);
#pragma unroll
                        for (int j = 0; j < 4; ++j) { v0[j] = __builtin_amdgcn_rcpf(1.f + __builtin_amdgcn_exp2f(-(v0[j] + b0[j]) * 1.44269504f)); v1[j] = __builtin_amdgcn_rcpf(1.f + __builtin_amdgcn_exp2f(-(v1[j] + b1[j]) * 1.44269504f)); }
                    }
                    if (rot) {
                        f32x4 p0, p1;
#pragma unroll
                        for (int j = 0; j < 4; ++j) { p0[j] = __shfl_xor(v0[j], 32); p1[j] = __shfl_xor(v1[j], 32); }
                        const float c00 = cs0[0][0], s00 = cs0[0][1], c01 = cs0[0][2], s01 = cs0[0][3], c02 = cs0[1][0], s02 = cs0[1][1], c03 = cs0[1][2], s03 = cs0[1][3];
                        const float c10 = cs1[0][0], s10 = cs1[0][1], c11 = cs1[0][2], s11 = cs1[0][3], c12 = cs1[1][0], s12 = cs1[1][1], c13 = cs1[1][2], s13 = cs1[1][3];
                        const float sg = (fq < 2) ? -1.f : 1.f;
                        v0[0] = v0[0] * c00 + sg * p0[0] * s00; v0[1] = v0[1] * c01 + sg * p0[1] * s01; v0[2] = v0[2] * c02 + sg * p0[2] * s02; v0[3] = v0[3] * c03 + sg * p0[3] * s03;
                        v1[0] = v1[0] * c10 + sg * p1[0] * s10; v1[1] = v1[1] * c11 + sg * p1[1] * s11; v1[2] = v1[2] * c12 + sg * p1[2] * s12; v1[3] = v1[3] * c13 + sg * p1[3] * s13;
                    }
                    u32x4 w; w.x = pk2(v0[0], v0[1]); w.y = pk2(v0[2], v0[3]); w.z = pk2(v1[0], v1[1]); w.w = pk2(v1[2], v1[3]);
                    if (kind == K_GATE) {
                        u32x2 gq;
                        gq.x = (unsigned)(v0[0] * 255.f + 0.5f) | ((unsigned)(v0[1] * 255.f + 0.5f) << 8) | ((unsigned)(v0[2] * 255.f + 0.5f) << 16) | ((unsigned)(v0[3] * 255.f + 0.5f) << 24);
                        gq.y = (unsigned)(v1[0] * 255.f + 0.5f) | ((unsigned)(v1[1] * 255.f + 0.5f) << 8) | ((unsigned)(v1[2] * 255.f + 0.5f) << 16) | ((unsigned)(v1[3] * 255.f + 0.5f) << 24);
                        *(u32x2*)((char*)u.O + (size_t)(((u.row0 >> 8) * 32 + (u.col0 >> 8)) * 16 + (ai * 4 + m) * 2 + bj) * 4096 + ((wr * 4 + wc) * 64 + fq * 16 + fr) * 8) = gq;
                    } else if (kind == K_VTP4 || kind == K_VTP16) {
                        const int tok0 = u.col0 + bj * 128 + wc * 32 + 8 * fq, b_ = tok0 >> 11, s0 = tok0 & (SEQ - 1);
                        bf16_t* orow = O + (size_t)r * ldc - (u.col0) + (size_t)b_ * SEQ;
                        if (kind == K_VTP4) { const int ub = s0 >> 2;
                            *(unsigned*)(orow + 0 * 512 + ub) = (w.x & 0xffffu) | (w.z << 16); *(unsigned*)(orow + 1 * 512 + ub) = (w.x >> 16) | (w.z & 0xffff0000u);
                            *(unsigned*)(orow + 2 * 512 + ub) = (w.y & 0xffffu) | (w.w << 16); *(unsigned*)(orow + 3 * 512 + ub) = (w.y >> 16) | (w.w & 0xffff0000u);
                        } else { const int rho0 = s0 & 15, ub = s0 >> 4;
                            orow[(rho0 + 0) * 128 + ub] = (bf16_t)(w.x & 0xffffu); orow[(rho0 + 1) * 128 + ub] = (bf16_t)(w.x >> 16); orow[(rho0 + 2) * 128 + ub] = (bf16_t)(w.y & 0xffffu); orow[(rho0 + 3) * 128 + ub] = (bf16_t)(w.y >> 16);
                            orow[(rho0 + 4) * 128 + ub] = (bf16_t)(w.z & 0xffffu); orow[(rho0 + 5) * 128 + ub] = (bf16_t)(w.z >> 16); orow[(rho0 + 6) * 128 + ub] = (bf16_t)(w.w & 0xffffu); orow[(rho0 + 7) * 128 + ub] = (bf16_t)(w.w >> 16); }
                    } else *(u32x4*)(rowp + bj * 128) = w;
                }
            }
    }
};

struct EpiPlain {
    static constexpr bool PERM = true;
    __device__ __forceinline__ void operator()(const f32x4 (&acc)[2][2][4][2], const Unit& u, int wr, int wc, int fr, int fq) const {
        bf16_t* O = (bf16_t*)u.O; const int ldc = u.ldc;
#pragma unroll
        for (int ai = 0; ai < 2; ++ai)
#pragma unroll
            for (int m = 0; m < 4; ++m) {
                bf16_t* rowp = O + (size_t)(ai * 128 + wr * 64 + m * 16 + fr) * ldc + wc * 32 + 8 * fq;
#pragma unroll
                for (int bj = 0; bj < 2; ++bj) { const f32x4 v0 = acc[ai][bj][m][0], v1 = acc[ai][bj][m][1];
                    u32x4 w; w.x = pk2(v0[0], v0[1]); w.y = pk2(v0[2], v0[3]); w.z = pk2(v1[0], v1[1]); w.w = pk2(v1[2], v1[3]); *(u32x4*)(rowp + bj * 128) = w; }
            }
    }
};

struct EpiBranch {
    static constexpr bool PERM = true;
    const char* G; char* PB; bf16_t* MG;
    __device__ __forceinline__ void operator()(const f32x4 (&acc)[2][2][4][2], const Unit& u, int wr, int wc, int fr, int fq) const {
        const int seg = u.kind; const int pm = u.row0 >> 8, pn = u.col0 >> 8;
        const size_t lo_ = (size_t)((wr * 4 + wc) * 64 + fq * 16 + fr) * 16;
        const char* gt = G + (size_t)((pm * 32 + seg * 8 + pn) * 16) * 4096 + (lo_ >> 1);
        char* pt = PB + (size_t)((pm * 8 + pn) * 16) * 8192 + lo_;
#pragma unroll
        for (int ai = 0; ai < 2; ++ai) {
            u32x2 g[4][2]; u32x4 pq[4][2];
#pragma unroll
            for (int m = 0; m < 4; ++m)
#pragma unroll
                for (int bj = 0; bj < 2; ++bj) { const int o = ((ai * 4 + m) * 2 + bj) * 8192; g[m][bj] = *(const u32x2*)(gt + (o >> 1)); if (seg > 0) pq[m][bj] = *(const u32x4*)(pt + o); }
#pragma unroll
            for (int m = 0; m < 4; ++m)
#pragma unroll
                for (int bj = 0; bj < 2; ++bj) {
                    const u32x2 gg = g[m][bj]; constexpr float GS = 1.f / 255.f;
                    f32x4 v0 = acc[ai][bj][m][0], v1 = acc[ai][bj][m][1];
                    v0[0] *= (float)(gg.x & 255u) * GS; v0[1] *= (float)((gg.x >> 8) & 255u) * GS; v0[2] *= (float)((gg.x >> 16) & 255u) * GS; v0[3] *= (float)(gg.x >> 24) * GS;
                    v1[0] *= (float)(gg.y & 255u) * GS; v1[1] *= (float)((gg.y >> 8) & 255u) * GS; v1[2] *= (float)((gg.y >> 16) & 255u) * GS; v1[3] *= (float)(gg.y >> 24) * GS;
                    if (seg > 0) { const u32x4 q = pq[m][bj];
                        v0[0] += bf_lo(q.x); v0[1] += bf_hi(q.x); v0[2] += bf_lo(q.y); v0[3] += bf_hi(q.y); v1[0] += bf_lo(q.z); v1[1] += bf_hi(q.z); v1[2] += bf_lo(q.w); v1[3] += bf_hi(q.w); }
                    u32x4 w; w.x = pk2(v0[0], v0[1]); w.y = pk2(v0[2], v0[3]); w.z = pk2(v1[0], v1[1]); w.w = pk2(v1[2], v1[3]);
                    if (seg < 3) *(u32x4*)(pt + ((ai * 4 + m) * 2 + bj) * 8192) = w;
                    else { const int r = u.row0 + ai * 128 + wr * 64 + m * 16 + fr, c = u.col0 + bj * 128 + wc * 32 + 8 * fq; *(u32x4*)(MG + (size_t)r * D + c) = w; }
                }
        }
    }
};

template <bool SC8> struct EpiResidT {
    static constexpr bool PERM = false;
    const float* Xin; float* Xout; int ldc;
    __device__ __forceinline__ void operator()(const f32x4 (&acc)[2][2][4][2], const Unit& u, int wr, int wc, int fr, int fq) const {
#pragma unroll
        for (int ai = 0; ai < 2; ++ai)
#pragma unroll
            for (int m = 0; m < 4; ++m) {
                const int r = u.row0 + ai * 128 + wr * 64 + m * 16 + fr;
                if (r < u.lim) {
#pragma unroll
                    for (int bj = 0; bj < 2; ++bj)
#pragma unroll
                        for (int n = 0; n < 2; ++n) {
                            const size_t off = (size_t)r * ldc + u.col0 + bj * 128 + wc * 32 + n * 16 + 4 * fq;
                            f32x4 v = acc[ai][bj][m][n]; if constexpr (SC8) v = v * (1.f / (float)(1 << (F8S_ACT + F8S_WD)));
                            if (Xin) v += *(const f32x4*)(Xin + off);
                            *(f32x4*)(Xout + off) = v;
                        }
                }
            }
    }
};
typedef EpiResidT<false> EpiResid;

template <bool MOE> struct EpiSwigluT {
    static constexpr bool PERM = true;
    __device__ __forceinline__ void operator()(const f32x4 (&acc)[2][2][4][2], const Unit& u, int wr, int wc, int fr, int fq) const {
        constexpr bool OUTF8 = MOE ? (F8_DN != 0) : (F8_DFD != 0); constexpr int PITCH = MOE ? EFF : DFF;
        constexpr float sc = (MOE && F8_GU) ? 1.f / (float)(1 << (F8S_H + F8S_WGU)) : 1.f;
#pragma unroll
        for (int ai = 0; ai < 2; ++ai)
#pragma unroll
            for (int m = 0; m < 4; ++m) {
                const int r = u.row0 + ai * 128 + wr * 64 + m * 16 + fr;
                float o[8];
#pragma unroll
                for (int n = 0; n < 2; ++n)
#pragma unroll
                    for (int j = 0; j < 4; ++j) { const float g = acc[ai][0][m][n][j] * sc, uu = acc[ai][1][m][n][j] * sc; o[n * 4 + j] = g * __builtin_amdgcn_rcpf(1.f + __builtin_amdgcn_exp2f(-g * 1.44269504f)) * uu; }
                if (r < u.lim) {
                    if constexpr (OUTF8) { const float q = (float)(1 << F8S_ACT); u32x2 w; w.x = pk4f8(o[0] * q, o[1] * q, o[2] * q, o[3] * q); w.y = pk4f8(o[4] * q, o[5] * q, o[6] * q, o[7] * q);
                        *(u32x2*)(u.O + (size_t)r * PITCH + u.col0 + wc * 32 + 8 * fq) = w; }
                    else { u32x4 w; w.x = pk2(o[0], o[1]); w.y = pk2(o[2], o[3]); w.z = pk2(o[4], o[5]); w.w = pk2(o[6], o[7]);
                        *(u32x4*)((bf16_t*)u.O + (size_t)r * PITCH + u.col0 + wc * 32 + 8 * fq) = w; } }
            }
    }
};

struct SchedP1 {
    int G, c, l; unsigned char* ws; int part = -1;
    __device__ __forceinline__ bool next(int i, Unit& u) const {
        int L = i * G + c;
        if (F8_Z0) { if (part == 0) { if (L >= 384) return false; L += 480; } else if (part == 1) { if (L >= 1528) return false; L = L < 480 ? L : L + 384; } else if (L >= 1912) return false; }
        else if (part == 0) { if (L >= 888) return false; if (L >= 864) L += 1024; } else if (part == 1) { if (L >= 1024) return false; L += 864; } else if (L >= 1912) return false;
        const bool f8 = (F8_P1 && l == 1) || (F8_G0 && l == 0 && part == 1);
        const char* H = (const char*)(ws + ((f8 && l == 0) ? WS_H8 : WS_H)); const char* MEMN = (const char*)(ws + WS_MEMN) + (size_t)l * 1024 * D * 2; const char* WMEM = (const char*)(ws + WS_WMEM) + (size_t)l * 1536 * D * 2;
        const size_t RP = f8 ? 2048 : 4096;
        u.nt = f8 ? 16 : 32; u.lim = 1 << 30; u.kind = K_PLAIN; u.lda2 = (unsigned)RP; u.ldb2 = (unsigned)RP;
        int pm, pn;
        if (L < 480) { g8::tile_map(L, 32, 15, pm, pn); u.A = H + (size_t)pm * 256 * RP; u.B = (const char*)(ws + WS_WIN) + (size_t)l * ZC * D * 2 + (size_t)pn * 256 * RP;
            u.O = (char*)(ws + WS_Z) + ((size_t)pm * 256 * ZC + pn * 256) * 2; u.ldc = ZC; u.row0 = pm * 256; u.col0 = pn * 256; if (pn >= 6 && pn < 12) u.kind = K_ZROT; return true; }
        L -= 480;
        if (L < 384) { g8::tile_map(L, 12, 32, pm, pn); u.A = (const char*)(ws + WS_WS) + (size_t)l * SWR * D * 2 + (size_t)pm * 256 * RP; u.B = H + (size_t)pn * 256 * RP; u.row0 = pm * 256; u.col0 = pn * 256;
            if (pm < 6) { u.O = (char*)(ws + WS_VT) + ((size_t)pm * 256 * T + pn * 256) * 2; u.ldc = T; if (pm == 4) u.kind = K_VTP4; if (pm == 5) u.kind = K_VTP16; }
            else { const int q = pm - 6, cs = q / 3, n0 = (q % 3) * 256, b = pn >> 3, s0 = (pn & 7) * 256; u.O = (char*)(ws + WS_UT) + (((size_t)(b * 768 + n0)) * 4096 + cs * 2048 + s0) * 2; u.ldc = 4096; }
            return true; }
        L -= 384;
        if (L < 1024) { g8::tile_map(L, 32, 32, pm, pn); u.A = H + (size_t)pm * 256 * RP; u.B = (const char*)(ws + WS_WG) + (size_t)l * 8192 * D * 2 + (size_t)pn * 256 * RP;
            u.O = (char*)(ws + WS_G); u.ldc = 8192; u.row0 = pm * 256; u.col0 = pn * 256; u.kind = K_GATE; return true; }
        L -= 1024;
        if (L < 12) { pm = L % 4; pn = L / 4; u.A = MEMN + (size_t)pm * 256 * RP; u.B = WMEM + (size_t)pn * 256 * RP;
            u.O = (char*)(ws + WS_KM) + ((size_t)pm * 256 * 768 + pn * 256) * 2; u.ldc = 768; u.row0 = pm * 256; u.col0 = pn * 256; return true; }
        L -= 12;
        pm = L % 3; pn = L / 3; u.A = WMEM + (size_t)(768 + pm * 256) * RP; u.B = MEMN + (size_t)pn * 256 * RP;
        u.O = (char*)(ws + WS_VMT) + ((size_t)pm * 256 * 1024 + pn * 256) * 2; u.ldc = 1024; u.row0 = pm * 256; u.col0 = pn * 256; return true;
    }
};
struct SchedDFT {
    int c; unsigned char* ws;
    __device__ __forceinline__ bool next(int i, Unit& u) const {
        if (i > 0 || c >= 96) return false;
        const int b = c / 24, rem = c % 24, pm = rem & 7, pn = rem >> 3;
        u.A = (const char*)(ws + WS_DFT) + (size_t)pm * 256 * 8192; u.B = (const char*)(ws + WS_UT) + (size_t)(b * 768 + pn * 256) * 8192; u.lda2 = 8192; u.ldb2 = 8192; u.nt = 64; u.kind = K_PLAIN; u.lim = 1 << 30;
        u.row0 = b * 2048 + pm * 256; u.col0 = pn * 256; u.O = (char*)(ws + WS_YB) + ((size_t)u.row0 * 768 + u.col0) * 2; u.ldc = 768; return true;
    }
};
struct SchedP3 {
    int G, c, l; unsigned char* ws;
    __device__ __forceinline__ bool next(int i, Unit& u) const {
        const int ti = i >> 2, seg = i & 3; const int L = ti * G + c; if (L >= 256) return false;
        int pm, pn; g8::tile_map(L, 32, 8, pm, pn);
        const int kseg = (seg == 2) ? 256 : 768;
        const size_t ao = seg == 0 ? WS_YA : seg == 1 ? WS_YB : seg == 2 ? WS_YC : WS_YM;
        const size_t wo = seg == 0 ? 0 : seg == 1 ? 3 * MiB : seg == 2 ? 6 * MiB : 7 * MiB;
        u.A = (const char*)(ws + ao) + (size_t)pm * 256 * kseg * 2; u.B = (const char*)(ws + WS_WBR) + (size_t)l * 10 * MiB + wo + (size_t)pn * 256 * kseg * 2; u.lda2 = kseg * 2; u.ldb2 = kseg * 2; u.nt = kseg / 64; u.kind = seg;
        u.row0 = pm * 256; u.col0 = pn * 256; u.lim = 1 << 30; u.O = nullptr; u.ldc = 0; return true;
    }
};
struct SchedSimple {
    int G, c; const char *A, *B; unsigned lda2, ldb2; int nM, nN, nt, colmul; char* O = nullptr;
    __device__ __forceinline__ bool next(int i, Unit& u) const {
        const int L = i * G + c; if (L >= nM * nN) return false;
        int pm, pn; g8::tile_map(L, nM, nN, pm, pn);
        u.A = A + (size_t)pm * 256 * lda2; u.B = B + (size_t)pn * 256 * ldb2; u.lda2 = lda2; u.ldb2 = ldb2; u.nt = nt; u.kind = 0; u.row0 = pm * 256; u.col0 = pn * colmul; u.lim = 1 << 30; u.O = O; u.ldc = 0; return true;
    }
};
struct SchedMoe {
    int G, c; const char *A, *B; unsigned lda2, ldb2; size_t wstride; int nN, nt, colmul; const int* cntp; char* O;
    __device__ __forceinline__ bool next(int i, Unit& u) const {
        int L = i * G + c; int off = 0;
        for (int e = 0; e < 8; ++e) {
            const int ce = cntp[e]; const int rt = (ce + 255) >> 8, nu = rt * nN;
            if (L < nu) { int pm, pn; g8::tile_map(L, rt, nN, pm, pn);
                u.A = A + (size_t)(off + pm * 256) * lda2; u.B = B + (size_t)e * wstride + (size_t)pn * 256 * ldb2; u.lda2 = lda2; u.ldb2 = ldb2; u.nt = nt; u.kind = 0;
                u.row0 = off + pm * 256; u.col0 = pn * colmul; u.lim = off + ce; u.O = O; u.ldc = 0; return true; }
            L -= nu; off += ce;
        }
        return false;
    }
};

struct MoeDownPlan { int rt[8], rtm[8], off[8], cnt[8]; int rounds, R, S, split_start, trows; };
__device__ __forceinline__ void moe_down_plan(const int* cntp, int G, MoeDownPlan& P) {
    int nrt = 0, o = 0;
#pragma unroll
    for (int e = 0; e < 8; ++e) { P.cnt[e] = cntp[e]; P.rt[e] = (P.cnt[e] + 255) >> 8; P.off[e] = o; o += P.cnt[e]; nrt += P.rt[e]; }
    const int NU = nrt * 8; P.R = NU % G; P.rounds = NU / G;
    int sf = P.R > 0 ? G / P.R : 1; P.S = sf >= 7 ? 7 : sf >= 4 ? 4 : sf >= 2 ? 2 : 1;
    int tr = P.R / 8; P.split_start = o;
#pragma unroll
    for (int e = 7; e >= 0; --e) { const int t = tr < P.rt[e] ? tr : P.rt[e]; P.rtm[e] = P.rt[e] - t; tr -= t; if (t > 0) P.split_start = P.off[e] + P.rtm[e] * 256; }
    P.trows = o - P.split_start;
}
struct SchedMoeDown {
    int G, c; const char *A, *B; unsigned lda2, ldb2; size_t wstride; int ntu; const int* cntp; char *O0, *PB;
    __device__ __forceinline__ bool next(int i, Unit& u) const {
        MoeDownPlan P; moe_down_plan(cntp, G, P);
        u.lda2 = lda2; u.ldb2 = ldb2; u.kind = 0; u.ldc = D;
        if (i < P.rounds) {
            int L = i * G + c;
#pragma unroll
            for (int e = 0; e < 8; ++e) { const int nu = P.rtm[e] * 8;
                if (L < nu) { int pm, pn; g8::tile_map(L, P.rtm[e], 8, pm, pn);
                    u.row0 = P.off[e] + pm * 256; u.col0 = pn * 256; u.lim = P.off[e] + P.cnt[e]; u.nt = ntu;
                    u.A = A + (size_t)u.row0 * lda2; u.B = B + (size_t)e * wstride + (size_t)pn * 256 * ldb2; u.O = O0 + (size_t)u.row0 * D * 2; return true; }
                L -= nu; }
            return false;
        }
        if (i > P.rounds || c >= P.R * P.S) return false;
        const int ut = c / P.S, part = c - ut * P.S, pn = ut & 7; int q = ut >> 3; const int ntp = ntu / P.S;
#pragma unroll
        for (int e = 0; e < 8; ++e) { const int te = P.rt[e] - P.rtm[e];
            if (q < te) { const int pm = P.rtm[e] + q;
                u.row0 = P.off[e] + pm * 256; u.col0 = pn * 256; u.lim = P.off[e] + P.cnt[e]; u.nt = ntp;
                u.A = A + (size_t)u.row0 * lda2 + (size_t)(part * ntp) * 128; u.B = B + (size_t)e * wstride + (size_t)pn * 256 * ldb2 + (size_t)(part * ntp) * 128;
                u.O = PB + ((size_t)part * P.trows + (u.row0 - P.split_start)) * D * 4; u.kind = 1; return true; }
            q -= te; }
        return false;
    }
};
struct EpiMoeDown {
    static constexpr bool PERM = false;
    __device__ __forceinline__ void operator()(const f32x4 (&acc)[2][2][4][2], const Unit& u, int wr, int wc, int fr, int fq) const {
        float* O = (float*)u.O;
#pragma unroll
        for (int ai = 0; ai < 2; ++ai)
#pragma unroll
            for (int m = 0; m < 4; ++m) {
                const int rl = ai * 128 + wr * 64 + m * 16 + fr;
                if (u.row0 + rl < u.lim) {
#pragma unroll
                    for (int bj = 0; bj < 2; ++bj)
#pragma unroll
                        for (int n = 0; n < 2; ++n) { const f32x4 v = acc[ai][bj][m][n] * (F8_DN ? 1.f / (float)(1 << (F8S_ACT + F8S_WD)) : 1.f); const size_t off = (size_t)rl * D + u.col0 + bj * 128 + wc * 32 + n * 16 + 4 * fq;
                            if (u.kind) *(f32x4*)(O + off) = v; else { u32x2 w; w.x = pk2(v.x, v.y); w.y = pk2(v.z, v.w); *(u32x2*)((bf16_t*)u.O + off) = w; } }
                }
            }
    }
};

struct UnitTab {
    const LAS u32x4* tab;
    __device__ __forceinline__ bool next(int i, Unit& u) const {
        if (i >= 32) return false;
        const u32x4 q0 = tab[i * 4 + 0], q1 = tab[i * 4 + 1], q2 = tab[i * 4 + 2], q3 = tab[i * 4 + 3];
#define RFL(x) ((unsigned)__builtin_amdgcn_readfirstlane((int)(x)))
        u.nt = (int)RFL(q2.y); if (u.nt == 0) return false;
        u.A = (const char*)(GAS const char*)(((unsigned long long)RFL(q0.y) << 32) | RFL(q0.x)); u.B = (const char*)(GAS const char*)(((unsigned long long)RFL(q0.w) << 32) | RFL(q0.z)); u.O = (char*)(GAS char*)(((unsigned long long)RFL(q1.y) << 32) | RFL(q1.x));
        u.lda2 = RFL(q1.z); u.ldb2 = RFL(q1.w); u.ldc = (int)RFL(q2.x); u.kind = (int)RFL(q2.z); u.row0 = (int)RFL(q2.w); u.col0 = (int)RFL(q3.x); u.lim = (int)RFL(q3.y);
#undef RFL
        return true;
    }
};
template <class Sched> __device__ __forceinline__ UnitTab build_units(LAS unsigned char* lds, const Sched& S) {
    LAS u32x4* tab = (LAS u32x4*)(lds + UTAB_OFF);
    __syncthreads();
    if (threadIdx.x < 32) { Unit u; const bool ok = S.next((int)threadIdx.x, u); const int t = threadIdx.x;
        const unsigned long long a = (unsigned long long)u.A, b = (unsigned long long)u.B, o = (unsigned long long)u.O;
        tab[t * 4 + 0] = (u32x4){(unsigned)a, (unsigned)(a >> 32), (unsigned)b, (unsigned)(b >> 32)};
        tab[t * 4 + 1] = (u32x4){(unsigned)o, (unsigned)(o >> 32), u.lda2, u.ldb2};
        tab[t * 4 + 2] = (u32x4){(unsigned)u.ldc, ok ? (unsigned)u.nt : 0u, (unsigned)u.kind, (unsigned)u.row0};
        tab[t * 4 + 3] = (u32x4){(unsigned)u.col0, (unsigned)u.lim, 0u, 0u}; }
    __syncthreads();
    UnitTab T_; T_.tab = tab; return T_;
}

struct Args { const float* in[23]; float* out; unsigned char* ws; int ph_lo, ph_hi; };
typedef const __attribute__((address_space(4))) Args* KArgsPtr;
__device__ __forceinline__ KArgsPtr kargs() { unsigned long long p = (unsigned long long)__builtin_amdgcn_kernarg_segment_ptr(); asm volatile("" : "+s"(p)); return (KArgsPtr)p; }
struct Frame {
    LAS unsigned char* lds; volatile LAS unsigned* MISC;
    int tid, lane, wave, G, bx;
};
__device__ __forceinline__ float wave_sum(float v) {
#pragma unroll
    for (int o = 1; o < 64; o <<= 1) v += __shfl_xor(v, o);
    return v;
}

struct TrJob { const float* src; bf16_t* dst; int ldn, K, mode, k0, n0, f8; };
__device__ __forceinline__ void tr_load(const TrJob& j, f32x4 (&v)[8], int lane) {
    const float* src = j.src + (size_t)(j.k0 + (lane >> 3)) * j.ldn + j.n0 + 4 * (lane & 7);
#pragma unroll
    for (int i = 0; i < 8; ++i) v[i] = *(const f32x4*)(src + (size_t)(8 * i) * j.ldn);
}
__device__ __forceinline__ void tr_store(const TrJob& j, const f32x4 (&v)[8], LAS float* scr, int lane) {
#pragma unroll
    for (int i = 0; i < 8; ++i)
#pragma unroll
        for (int e = 0; e < 4; ++e) scr[(8 * i + (lane >> 3)) * 33 + 4 * (lane & 7) + e] = v[i][e];
    LDS_WAIT(); asm volatile("" ::: "memory");
    const int c = lane & 7;
    if (j.f8) {
        const float sc = (float)(1 << j.f8);
#pragma unroll
        for (int q = 0; q < 4; ++q) { const int n = (lane >> 3) + 8 * q; const LAS float* s = scr + (8 * c) * 33 + n;
            u32x2 o; o.x = pk4f8(s[0 * 33] * sc, s[1 * 33] * sc, s[2 * 33] * sc, s[3 * 33] * sc); o.y = pk4f8(s[4 * 33] * sc, s[5 * 33] * sc, s[6 * 33] * sc, s[7 * 33] * sc);
            const int nn = j.n0 + n; const int drow = j.mode == 0 ? nn : ((nn >> 7) * 256 + (j.mode == 2 ? 128 : 0) + (nn & 127));
            *(u32x2*)((char*)j.dst + (size_t)drow * j.K + j.k0 + 8 * c) = o; }
    } else {
#pragma unroll
    for (int q = 0; q < 4; ++q) { const int n = (lane >> 3) + 8 * q; const LAS float* s = scr + (8 * c) * 33 + n;
        u32x4 o; o.x = pk2(s[0 * 33], s[1 * 33]); o.y = pk2(s[2 * 33], s[3 * 33]); o.z = pk2(s[4 * 33], s[5 * 33]); o.w = pk2(s[6 * 33], s[7 * 33]);
        const int nn = j.n0 + n; const int drow = j.mode == 0 ? nn : ((nn >> 7) * 256 + (j.mode == 2 ? 128 : 0) + (nn & 127));
        *(u32x4*)(j.dst + (size_t)drow * j.K + j.k0 + 8 * c) = o; }
    }
    LDS_WAIT(); asm volatile("" ::: "memory");
}
__device__ __forceinline__ void rms_row_bf16(const float* xrow, const float* gain, bf16_t* orow, int lane) {
    const f32x4* xr = (const f32x4*)xrow + lane; const f32x4* gr = (const f32x4*)gain + lane;
    f32x4 v[8]; float s = 0.f;
#pragma unroll
    for (int j = 0; j < 8; ++j) { v[j] = xr[64 * j]; s += (v[j].x * v[j].x + v[j].y * v[j].y) + (v[j].z * v[j].z + v[j].w * v[j].w); }
    const float rstd = __builtin_amdgcn_rsqf(wave_sum(s) * (1.f / D) + RMS_EPS);
    u32x2* o8 = (u32x2*)orow + lane;
#pragma unroll
    for (int j = 0; j < 8; ++j) { const f32x4 g = gr[64 * j]; u32x2 w; w.x = pk2(v[j].x * rstd * g.x, v[j].y * rstd * g.y); w.y = pk2(v[j].z * rstd * g.z, v[j].w * rstd * g.w); o8[64 * j] = w; }
}
__device__ __forceinline__ void rms_row_f8(const float* xrow, const float* gain, unsigned char* orow, int lane) {
    const f32x4* xr = (const f32x4*)xrow + lane; const f32x4* gr = (const f32x4*)gain + lane;
    f32x4 v[8]; float s = 0.f;
#pragma unroll
    for (int j = 0; j < 8; ++j) { v[j] = xr[64 * j]; s += (v[j].x * v[j].x + v[j].y * v[j].y) + (v[j].z * v[j].z + v[j].w * v[j].w); }
    const float rstd = __builtin_amdgcn_rsqf(wave_sum(s) * (1.f / D) + RMS_EPS) * (float)(1 << F8S_H);
    unsigned* o4 = (unsigned*)orow + lane;
#pragma unroll
    for (int j = 0; j < 8; ++j) { const f32x4 g = gr[64 * j]; o4[64 * j] = pk4f8(v[j].x * rstd * g.x, v[j].y * rstd * g.y, v[j].z * rstd * g.z, v[j].w * rstd * g.w); }
}
__device__ __forceinline__ void rms_row_bf16_f8(const float* xrow, const float* gain, bf16_t* orow, unsigned char* orow8, int lane) {
    const f32x4* xr = (const f32x4*)xrow + lane; const f32x4* gr = (const f32x4*)gain + lane;
    f32x4 v[8]; float s = 0.f;
#pragma unroll
    for (int j = 0; j < 8; ++j) { v[j] = xr[64 * j]; s += (v[j].x * v[j].x + v[j].y * v[j].y) + (v[j].z * v[j].z + v[j].w * v[j].w); }
    const float rstd = __builtin_amdgcn_rsqf(wave_sum(s) * (1.f / D) + RMS_EPS);
    u32x2* o8 = (u32x2*)orow + lane; unsigned* o4 = (unsigned*)orow8 + lane; const float q = (float)(1 << F8S_H);
#pragma unroll
    for (int j = 0; j < 8; ++j) { const f32x4 g = gr[64 * j]; const float a = v[j].x * rstd * g.x, b = v[j].y * rstd * g.y, c = v[j].z * rstd * g.z, d = v[j].w * rstd * g.w;
        u32x2 w; w.x = pk2(a, b); w.y = pk2(c, d); o8[64 * j] = w; o4[64 * j] = pk4f8(a * q, b * q, c * q, d * q); }
}
__constant__ float ROPE_F[16] = {1.591549431e-01f, 7.008652159e-02f, 3.086376340e-02f, 1.359137064e-02f, 5.985185713e-03f, 2.635675899e-03f, 1.160663641e-03f, 5.111175045e-04f,
                                 2.250790790e-04f, 9.911730937e-05f, 4.364795279e-05f, 1.922110068e-05f, 8.464330808e-06f, 3.727408602e-06f, 1.641426263e-06f, 7.228293069e-07f};

constexpr int CV_I_E = (D / 64) * (EFF / 32), CV_I_ED = (EFF / 64) * (D / 32), CV_I_EXP = 8 * (2 * CV_I_E + CV_I_ED);
constexpr int N_FILL = 36;
constexpr int FILL1_BLK0 = 120, FILL3_BLK0 = 128;
constexpr int N_FILL2 = 6;
constexpr int FILL1A_BLK0 = (F8_G0 && F8_Z0) ? 128 : FILL1_BLK0;
constexpr int N_DEF1 = (256 - FILL1_BLK0) * NWAVES * N_FILL, N_DEF3 = (256 - FILL3_BLK0) * NWAVES * N_FILL, N_DEF2 = 160 * NWAVES * N_FILL2;
constexpr int CONV_WG = 64, N_DEF1A = CV_I_EXP - (N_DEF1 + N_DEF3 + 2 * N_DEF2), CONV_CH = ((N_DEF1A + CONV_WG * NWAVES - 1) / (CONV_WG * NWAVES) + 1) & ~1;
constexpr int N_DEFER = N_DEF1A + N_DEF1 + N_DEF3 + 2 * N_DEF2;
static_assert(N_DEFER == CV_I_EXP && N_DEF1A > 0 && N_DEF1A % 2 == 0, "every expert item is deferred");
static_assert(N_FILL % 2 == 0 && N_FILL2 % 2 == 0 && N_DEF1 % 2 == 0 && N_DEF2 % 2 == 0 && N_DEF3 % 2 == 0 && CV_I_E % 2 == 0 && CV_I_ED % 2 == 0 && NWAVES % 2 == 0, "fp8 item pairs (2i, 2i+1) stay inside one workgroup");
__device__ __forceinline__ void expert_item_job(int r, TrJob& J) {
    KArgsPtr kb = kargs(); unsigned char* wsb = (unsigned char*)(GAS unsigned char*)kb->ws;
    const int e = r / (2 * CV_I_E + CV_I_ED); r -= e * (2 * CV_I_E + CV_I_ED);
    const float* src; bf16_t* dst; int ldn, K, ncols, mode;
    if (r < CV_I_E) { src = ((const float*)(GAS const float*)kb->in[19]) + (size_t)e * D * EFF; ldn = EFF; K = D; ncols = EFF; dst = (bf16_t*)(wsb + WS_EGU + (size_t)e * 14336 * D * (F8_GU ? 1 : 2)); mode = 1; }
    else if (r < 2 * CV_I_E) { r -= CV_I_E; src = ((const float*)(GAS const float*)kb->in[20]) + (size_t)e * D * EFF; ldn = EFF; K = D; ncols = EFF; dst = (bf16_t*)(wsb + WS_EGU + (size_t)e * 14336 * D * (F8_GU ? 1 : 2)); mode = 2; }
    else { r -= 2 * CV_I_E; src = ((const float*)(GAS const float*)kb->in[21]) + (size_t)e * EFF * D; ldn = D; K = EFF; ncols = D; dst = (bf16_t*)(wsb + WS_ED + (size_t)e * D * EFF * (F8_DN ? 1 : 2)); mode = 0; }
    const int g8 = (K >> 6) * 8, g = r / g8, rem = r - g * g8, kbk = 2 * (rem >> 4) + (rem & 1), nb = g * 8 + ((rem >> 1) & 7); (void)ncols;
    J.src = src; J.dst = dst; J.ldn = ldn; J.K = K; J.mode = mode; J.k0 = 64 * kbk; J.n0 = 32 * nb; J.f8 = mode == 0 ? (F8_DN ? F8S_WD : 0) : (F8_GU ? F8S_WGU : 0);
}
    constexpr int I_E = (D / 64) * (EFF / 32), I_ED = (EFF / 64) * (D / 32);
    constexpr int I_EXP = 8 * (2 * I_E + I_ED);
    constexpr int I_DG = (D / 64) * (DFF / 32), I_DDN = (DFF / 64) * (D / 32);
    constexpr int I_IN1 = 32 * (1536 / 32), I_IN2 = 32 * (768 / 32), I_MEM = 32 * (1536 / 32), I_BR = 12 * 64, I_BRC = 4 * 64, I_GT = 32 * 256, I_WO = 32 * 64;
    constexpr int I_LAYER = I_IN1 + I_IN2 + I_IN1 + I_IN2 + I_IN2 + I_MEM + 3 * I_BR + I_BRC + I_GT + I_WO;
    constexpr int NITEMS = I_EXP + 2 * I_DG + I_DDN + 2 * I_LAYER;
__device__ __forceinline__ void item_job(int it, TrJob& J) {
        KArgsPtr kb = kargs(); unsigned char* wsb = (unsigned char*)(GAS unsigned char*)kb->ws;
        int r = it; const float* src = nullptr; bf16_t* dst = nullptr; int ldn = 0, K = 0, col0 = 0, ncols = 32, mode = 0; bool done = false, p1f8 = false; const bool isexp0 = it < I_EXP || (F8_DFD && it >= I_EXP + 2 * I_DG && it < I_EXP + 2 * I_DG + I_DDN);
#define TJ(n_, src_, ldn_, K_, col0_, ncols_, dst_, mode_) if (!done) { if (r < (n_)) { src = (src_); ldn = (ldn_); K = (K_); col0 = (col0_); ncols = (ncols_); dst = (dst_); mode = (mode_); done = true; } else r -= (n_); }
        if (r < I_EXP) { const int e = r / (2 * I_E + I_ED); r -= e * (2 * I_E + I_ED);
            TJ(I_E, ((const float*)(GAS const float*)kb->in[19]) + (size_t)e * D * EFF, EFF, D, 0, EFF, (bf16_t*)(wsb + WS_EGU + (size_t)e * 14336 * D * (F8_GU ? 1 : 2)), 1)
            TJ(I_E, ((const float*)(GAS const float*)kb->in[20]) + (size_t)e * D * EFF, EFF, D, 0, EFF, (bf16_t*)(wsb + WS_EGU + (size_t)e * 14336 * D * (F8_GU ? 1 : 2)), 2)
            TJ(I_ED, ((const float*)(GAS const float*)kb->in[21]) + (size_t)e * EFF * D, D, EFF, 0, D, (bf16_t*)(wsb + WS_ED + (size_t)e * D * EFF * (F8_DN ? 1 : 2)), 0)
        } else { r -= I_EXP;
            TJ(I_DG, ((const float*)(GAS const float*)kb->in[15]), DFF, D, 0, DFF, (bf16_t*)(wsb + WS_DGU), 1)
            TJ(I_DG, ((const float*)(GAS const float*)kb->in[16]), DFF, D, 0, DFF, (bf16_t*)(wsb + WS_DGU), 2)
            TJ(I_DDN, ((const float*)(GAS const float*)kb->in[17]), D, DFF, 0, D, (bf16_t*)(wsb + WS_DD), 0)
            if (!done) { const int l = r / I_LAYER; r -= l * I_LAYER; const bool p1 = F8_P1 && l == 1, pz = p1 || (F8_G0 && F8_Z0 && l == 0);
#define ROF(f_, base_, rows_) ((f_) ? (bf16_t*)((char*)(base_) + (size_t)(rows_) * D) : (base_) + (size_t)(rows_) * D)
#define TJP(f_, n_, src_, ldn_, K_, col0_, ncols_, dst_, mode_) if (!done) { if (r < (n_)) { src = (src_); ldn = (ldn_); K = (K_); col0 = (col0_); ncols = (ncols_); dst = (dst_); mode = (mode_); p1f8 = (f_); done = true; } else r -= (n_); }
                bf16_t* WINl = (bf16_t*)(wsb + WS_WIN) + (size_t)l * ZC * D; bf16_t* WSl = (bf16_t*)(wsb + WS_WS) + (size_t)l * SWR * D; unsigned char* wbr = wsb + WS_WBR + (size_t)l * 10 * MiB;
                const float* win = ((const float*)(GAS const float*)kb->in[3]) + (size_t)l * D * 6144;
                TJP(pz, I_IN1, win, 6144, D, 0, 1536, WINl, 0)
                TJP(p1, I_IN2, win, 6144, D, 1536, 768, WSl, 0)
                TJP(pz, I_IN1, win, 6144, D, 2304, 1536, ROF(pz, WINl, 1536), 0)
                TJP(p1, I_IN2, win, 6144, D, 3840, 768, ROF(p1, WSl, 768), 0)
                TJP(pz, I_IN2, win, 6144, D, 5376, 768, ROF(pz, WINl, 3072), 0)
                TJP(pz, I_MEM, ((const float*)(GAS const float*)kb->in[6]) + (size_t)l * D * 1536, 1536, D, 0, 1536, (bf16_t*)(wsb + WS_WMEM) + (size_t)l * 1536 * D, 0)
                TJ(I_BR, ((const float*)(GAS const float*)kb->in[7]) + (size_t)l * 768 * D, D, 768, 0, D, (bf16_t*)(wbr), 0)
                TJ(I_BR, ((const float*)(GAS const float*)kb->in[8]) + (size_t)l * 768 * D, D, 768, 0, D, (bf16_t*)(wbr + 3 * MiB), 0)
                TJ(I_BRC, ((const float*)(GAS const float*)kb->in[9]) + (size_t)l * 256 * D, D, 256, 0, D, (bf16_t*)(wbr + 6 * MiB), 0)
                TJ(I_BR, ((const float*)(GAS const float*)kb->in[10]) + (size_t)l * 768 * D, D, 768, 0, D, (bf16_t*)(wbr + 7 * MiB), 0)
                if (!done) { if (r < I_GT) { src = ((const float*)(GAS const float*)kb->in[11]) + (size_t)l * D * 8192; ldn = 8192; K = D; col0 = 0; ncols = 8192; dst = (bf16_t*)(wsb + WS_WG) + (size_t)l * 8192 * D; mode = 0; p1f8 = p1 || (F8_G0 && l == 0); done = true; } else r -= I_GT; }
                TJ(I_WO, ((const float*)(GAS const float*)kb->in[13]) + (size_t)l * D * D, D, D, 0, D, (bf16_t*)(wsb + WS_WO) + (size_t)l * D * D, 0)
            }
        }
#undef TJ
#undef TJP
#undef ROF
        const bool isexp = isexp0 || p1f8; const int g8 = (K >> 6) * 8, g = r / g8, rem = r - g * g8, kbk = isexp ? 2 * (rem >> 4) + (rem & 1) : rem >> 3, nb = g * 8 + (isexp ? (rem >> 1) & 7 : rem & 7); (void)ncols;
        J.src = src + col0; J.dst = dst; J.ldn = ldn; J.K = K; J.mode = mode; J.k0 = 64 * kbk; J.n0 = 32 * nb; J.f8 = it < I_EXP ? (mode == 0 ? (F8_DN ? F8S_WD : 0) : (F8_GU ? F8S_WGU : 0)) : p1f8 ? F8S_WGU : isexp0 ? F8S_WD : 0;
}
template <bool ANY = false> __device__ __forceinline__ void cvt_fill(Frame& F, int first, int cnt = N_FILL) {
    int lane_ = (int)threadIdx.x; asm volatile("" : "+v"(lane_)); lane_ &= 63;
    LAS float* scr = (LAS float*)(F.lds + F.wave * 16384);
#define LOADJ(J, V, K_) do { const int k_ = (K_); if (ANY) item_job(first + (k_ < cnt ? k_ : cnt - 1), J); else expert_item_job(first + (k_ < cnt ? k_ : cnt - 1), J); tr_load(J, V, lane_); } while (0)
#pragma unroll 1
    for (int k = 0; k < cnt; k += 4) {
        TrJob ja, jb, jc, jd; f32x4 a[8], b[8], c[8], d[8];
        LOADJ(ja, a, k); LOADJ(jb, b, k + 1); LOADJ(jc, c, k + 2); LOADJ(jd, d, k + 3);
        tr_store(ja, a, scr, lane_); if (k + 1 < cnt) tr_store(jb, b, scr, lane_); if (k + 2 < cnt) tr_store(jc, c, scr, lane_); if (k + 3 < cnt) tr_store(jd, d, scr, lane_);
    }
#undef LOADJ
}
__device__ __forceinline__ void p0_prologue(Frame& F) {
    LAS float* scr = (LAS float*)(F.lds + F.wave * 16384);
    LAS f32x2* trig = (LAS f32x2*)(F.lds + XTAB_OFF);
    if (F.tid < 128) { const float a = (float)F.tid * (1.f / 64.f); trig[F.tid] = (f32x2){cospif(a) * 0.08838834765f, sinpif(a) * 0.08838834765f}; }
    __syncthreads();
    int lane_ = (int)threadIdx.x; asm volatile("" : "+v"(lane_)); lane_ &= 63;
    const int gw = F.bx * NWAVES + F.wave, NGW = F.G * NWAVES, lane = lane_;
    KArgsPtr ka = kargs(); unsigned char* ws = (unsigned char*)(GAS unsigned char*)ka->ws;
    for (int it = (F.G == 256) ? ((F.wave < 4 && F.bx < 192) ? F.bx * 4 + F.wave : 768) : gw; it < 768; it += (F.G == 256) ? 768 : NGW) {
        const int l = it / 384, rem = it % 384, g = rem / 64, k0 = (rem % 64) * 32;
        const float* W = ((const float*)(GAS const float*)ka->in[3]) + (size_t)l * D * 6144 + 4608 + g * 128;
#pragma unroll 8
        for (int kk = 0; kk < 32; ++kk) { const f32x2 w = *(const f32x2*)(W + (size_t)(k0 + kk) * 6144 + 2 * lane); *(LAS f32x2*)(scr + kk * 128 + 2 * lane) = w; }
        LDS_WAIT(); asm volatile("" ::: "memory");
        bf16_t* dst = (bf16_t*)(ws + WS_WS) + (size_t)l * SWR * D + (size_t)(1536 + g * 128) * D;
        for (int kc = 0; kc < 4; ++kc) {
            float a[2][2][8];
#pragma unroll
            for (int p = 0; p < 2; ++p)
#pragma unroll
                for (int q = 0; q < 2; ++q)
#pragma unroll
                    for (int k = 0; k < 8; ++k) a[p][q][k] = 0.f;
            for (int c = 0; c < 128; ++c) {
                const f32x2 t0 = trig[(c * lane) & 127], t1 = trig[(c * (lane + 64)) & 127];
#pragma unroll
                for (int k = 0; k < 8; ++k) { const float w = scr[(kc * 8 + k) * 128 + c]; a[0][0][k] += w * t0.x; a[0][1][k] += w * t0.y; a[1][0][k] += w * t1.x; a[1][1][k] += w * t1.y; }
            }
#pragma unroll
            for (int p = 0; p < 2; ++p)
#pragma unroll
                for (int q = 0; q < 2; ++q) {
                    if (F8_P1 && l == 1) { const float sc = (float)(1 << F8S_WGU); u32x2 o; o.x = pk4f8(a[p][q][0] * sc, a[p][q][1] * sc, a[p][q][2] * sc, a[p][q][3] * sc); o.y = pk4f8(a[p][q][4] * sc, a[p][q][5] * sc, a[p][q][6] * sc, a[p][q][7] * sc);
                        *(u32x2*)((char*)(ws + WS_WS) + (size_t)l * SWR * D * 2 + (size_t)(1536 + g * 128 + q * 768 + lane + 64 * p) * D + k0 + kc * 8) = o; }
                    else { u32x4 o; o.x = pk2(a[p][q][0], a[p][q][1]); o.y = pk2(a[p][q][2], a[p][q][3]); o.z = pk2(a[p][q][4], a[p][q][5]); o.w = pk2(a[p][q][6], a[p][q][7]);
                        *(u32x4*)(dst + (size_t)(q * 768 + lane + 64 * p) * D + k0 + kc * 8) = o; } }
        }
        LDS_WAIT(); asm volatile("" ::: "memory");
    }
    for (int it = gw; it < 2048; it += NGW) {
        bf16_t* row = (bf16_t*)(ws + WS_DFT) + (size_t)it * 4096;
#pragma unroll 2
        for (int j = 0; j < 8; ++j) { const int c0 = 8 * (lane + 64 * j); float v[8];
#pragma unroll
            for (int e = 0; e < 8; ++e) { const int cc = c0 + e, k = cc & 2047; const float a = (float)((it * k) & 2047) * (1.f / 1024.f); v[e] = (cc < 2048 ? cospif(a) : -sinpif(a)) * 0.02209708691f; }
            u32x4 o; o.x = pk2(v[0], v[1]); o.y = pk2(v[2], v[3]); o.z = pk2(v[4], v[5]); o.w = pk2(v[6], v[7]); *(u32x4*)(row + c0) = o; }
    }
    for (int it = gw; it < 512; it += NGW) {
        const int pos = it * 4 + (lane >> 4), i = lane & 15; const float f = ROPE_F[i], p = (float)pos;
        const float hi = p * f, lo = fmaf(p, f, -hi); const float fr = (hi - floorf(hi)) + lo;
        ((f32x2*)(ws + WS_TAB))[pos * 16 + i] = (f32x2){cospif(2.f * fr), sinpif(2.f * fr)};
    }
    for (int it = gw; it < T + 2 * 1024; it += NGW) {
        if (it < T) { if (F8_G0) rms_row_bf16_f8(((const float*)(GAS const float*)ka->in[0]) + (size_t)it * D, ((const float*)(GAS const float*)ka->in[2]), (bf16_t*)(ws + WS_H) + (size_t)it * D, (unsigned char*)(ws + WS_H8) + (size_t)it * D, lane);
            else rms_row_bf16(((const float*)(GAS const float*)ka->in[0]) + (size_t)it * D, ((const float*)(GAS const float*)ka->in[2]), (bf16_t*)(ws + WS_H) + (size_t)it * D, lane); }
        else { const int l = (it - T) >> 10, r = (it - T) & 1023;
            if ((F8_P1 && l == 1) || (F8_G0 && F8_Z0 && l == 0)) rms_row_f8(((const float*)(GAS const float*)ka->in[1]) + (size_t)r * D, ((const float*)(GAS const float*)ka->in[5]) + l * D, (unsigned char*)(ws + WS_MEMN) + (size_t)l * 1024 * D * 2 + (size_t)r * D, lane);
            else rms_row_bf16(((const float*)(GAS const float*)ka->in[1]) + (size_t)r * D, ((const float*)(GAS const float*)ka->in[5]) + l * D, (bf16_t*)(ws + WS_MEMN) + ((size_t)l * 1024 + r) * D, lane); }
    }
    const int ndef = (F.G == 256) ? N_DEFER : 0;
    const int NLIST = NITEMS - ndef - ((F.G == 256) ? I_LAYER : 0), DEF0 = I_EXP - ndef;
    static_assert(I_EXP == CV_I_EXP, "item counts");
    { constexpr int FOLD_DELTA = 14;
      const bool g256 = F.G == 256, foldw = g256 && F.wave < 4 && F.bx < 192;
      const int idxnf = F.bx < 192 ? F.bx * 4 + (F.wave - 4) : 768 + (F.bx - 192) * NWAVES + F.wave;
      const int Rc = g256 ? (NLIST - 1280 * FOLD_DELTA) / 2048 : 0, rem0 = NLIST - Rc * 2048;
      const int n = g256 ? Rc + (foldw ? 0 : (rem0 - idxnf + 1279) / 1280) : (NLIST - gw + NGW - 1) / NGW;
#define LOADJ(J, V, K_) do { const int kk_ = (K_) < n ? (K_) : n - 1; int i_ = g256 ? (kk_ < Rc ? gw + kk_ * 2048 : Rc * 2048 + idxnf + (kk_ - Rc) * 1280) : gw + kk_ * NGW; i_ = i_ < NLIST ? i_ : NLIST - 1; item_job(i_ < DEF0 ? i_ : i_ + ndef, J); tr_load(J, V, lane); } while (0)
#pragma unroll 1
      for (int k = 0; k < n; k += 4) {
          TrJob ja, jb, jc, jd; f32x4 a[8], b[8], c[8], d[8];
          LOADJ(ja, a, k); LOADJ(jb, b, k + 1); LOADJ(jc, c, k + 2); LOADJ(jd, d, k + 3);
          tr_store(ja, a, scr, lane); if (k + 1 < n) tr_store(jb, b, scr, lane); if (k + 2 < n) tr_store(jc, c, scr, lane); if (k + 3 < n) tr_store(jd, d, scr, lane);
      }
#undef LOADJ
    }
}

#define MFMA32(a, b, c) __builtin_amdgcn_mfma_f32_32x32x16_bf16((a), (b), (c), 0, 0, 0)
__device__ __forceinline__ int kperm(int r) { return (r & ~12) | ((r & 4) << 1) | ((r & 8) >> 1); }
__device__ __forceinline__ int acc_key(int i, int h) { return (i & 3) + 4 * ((i >> 2) & 1) + 8 * h + 16 * (i >> 3); }
template <int HD> struct AttnSt { f32x16 o[HD / 32]; float m, l; };
template <int HD> __device__ __forceinline__ void attn_init(AttnSt<HD>& st) {
#pragma unroll
    for (int b = 0; b < HD / 32; ++b)
#pragma unroll
        for (int i = 0; i < 16; ++i) st.o[b][i] = 0.f;
    st.m = -1e30f; st.l = 0.f;
}
template <int HD> __device__ __forceinline__ void load_k(bf16x8 (&kf)[HD / 16], const bf16_t* kp) {
#pragma unroll
    for (int kk = 0; kk < HD / 16; ++kk) kf[kk] = *(const bf16x8*)(kp + 16 * kk);
}
template <int HD> __device__ __forceinline__ void load_v(bf16x8 (&vf)[HD / 32][2], const bf16_t* vp, size_t ldv) {
#pragma unroll
    for (int b = 0; b < HD / 32; ++b)
#pragma unroll
        for (int h2 = 0; h2 < 2; ++h2) vf[b][h2] = *(const bf16x8*)(vp + (size_t)(32 * b) * ldv + 16 * h2);
}
template <int HD> __device__ __forceinline__ f32x16 attn_qk(const bf16x8 (&kf)[HD / 16], const bf16x8 (&qf)[HD / 16]) {
    f32x16 x;
#pragma unroll
    for (int i = 0; i < 16; ++i) x[i] = 0.f;
#pragma unroll
    for (int kk = 0; kk < HD / 16; ++kk) x = MFMA32(kf[kk], qf[kk], x);
    return x;
}
template <int HD, class MaskF>
__device__ __forceinline__ float attn_softmax(AttnSt<HD>& st, const f32x16& x, float sc, const MaskF& mf, bf16x8 (&xs)[2]) {
    float s[16]; bool ok[16]; float mt = -1e30f;
#pragma unroll
    for (int i = 0; i < 16; ++i) { float bias; ok[i] = mf(i, bias); s[i] = x[i] * sc + bias; mt = fmaxf(mt, ok[i] ? s[i] : -1e30f); }
    mt = fmaxf(mt, __shfl_xor(mt, 32));
    const float mn = fmaxf(st.m, mt), alpha = __builtin_amdgcn_exp2f(st.m - mn);
    float ps = 0.f; float p[16];
#pragma unroll
    for (int i = 0; i < 16; ++i) { p[i] = ok[i] ? __builtin_amdgcn_exp2f(s[i] - mn) : 0.f; ps += p[i]; }
    st.l = st.l * alpha + ps; st.m = mn;
#pragma unroll
    for (int h2 = 0; h2 < 2; ++h2) { u32x4 w; w.x = pk2(p[8 * h2 + 0], p[8 * h2 + 1]); w.y = pk2(p[8 * h2 + 2], p[8 * h2 + 3]); w.z = pk2(p[8 * h2 + 4], p[8 * h2 + 5]); w.w = pk2(p[8 * h2 + 6], p[8 * h2 + 7]); xs[h2] = __builtin_bit_cast(bf16x8, w); }
    return alpha;
}
template <int HD>
__device__ __forceinline__ void attn_pvmm(AttnSt<HD>& st, const bf16x8 (&vf)[HD / 32][2], const bf16x8 (&xs)[2], float alpha) {
#pragma unroll
    for (int b = 0; b < HD / 32; ++b) {
#pragma unroll
        for (int i = 0; i < 16; ++i) st.o[b][i] *= alpha;
#pragma unroll
        for (int h2 = 0; h2 < 2; ++h2) st.o[b] = MFMA32(vf[b][h2], xs[h2], st.o[b]);
    }
}
template <int HD, class MaskF>
__device__ __forceinline__ void attn_pv(AttnSt<HD>& st, const f32x16& x, const bf16x8 (&vf)[HD / 32][2], float sc, const MaskF& mf) {
    bf16x8 xs[2]; const float alpha = attn_softmax<HD>(st, x, sc, mf, xs); attn_pvmm<HD>(st, vf, xs, alpha);
}
template <int HD, class MaskF>
__device__ __forceinline__ void attn_pv_gv(AttnSt<HD>& st, const f32x16& x, const bf16_t* vp, size_t ldv, float sc, const MaskF& mf) {
    bf16x8 v0 = *(const bf16x8*)(vp), v1 = *(const bf16x8*)(vp + 16);
    float s[16]; bool ok[16]; float mt = -1e30f;
#pragma unroll
    for (int i = 0; i < 16; ++i) { float bias; ok[i] = mf(i, bias); s[i] = x[i] * sc + bias; mt = fmaxf(mt, ok[i] ? s[i] : -1e30f); }
    mt = fmaxf(mt, __shfl_xor(mt, 32));
    const float mn = fmaxf(st.m, mt), alpha = __builtin_amdgcn_exp2f(st.m - mn);
    float ps = 0.f; float p[16];
#pragma unroll
    for (int i = 0; i < 16; ++i) { p[i] = ok[i] ? __builtin_amdgcn_exp2f(s[i] - mn) : 0.f; ps += p[i]; }
    st.l = st.l * alpha + ps; st.m = mn;
    bf16x8 xs[2];
#pragma unroll
    for (int h2 = 0; h2 < 2; ++h2) { u32x4 w; w.x = pk2(p[8 * h2 + 0], p[8 * h2 + 1]); w.y = pk2(p[8 * h2 + 2], p[8 * h2 + 3]); w.z = pk2(p[8 * h2 + 4], p[8 * h2 + 5]); w.w = pk2(p[8 * h2 + 6], p[8 * h2 + 7]); xs[h2] = __builtin_bit_cast(bf16x8, w); }
#pragma unroll
    for (int b = 0; b < HD / 32; ++b) {
        bf16x8 n0 = v0, n1 = v1;
        if (b + 1 < HD / 32) { n0 = *(const bf16x8*)(vp + (size_t)(32 * (b + 1)) * ldv); n1 = *(const bf16x8*)(vp + (size_t)(32 * (b + 1)) * ldv + 16); }
#pragma unroll
        for (int i = 0; i < 16; ++i) st.o[b][i] *= alpha;
        st.o[b] = MFMA32(v0, xs[0], st.o[b]); st.o[b] = MFMA32(v1, xs[1], st.o[b]);
        v0 = n0; v1 = n1;
    }
}
template <int HD> __device__ __forceinline__ void attn_store(const AttnSt<HD>& st, bf16_t* yq  ) {
    const float lt = st.l + __shfl_xor(st.l, 32); const float inv = 1.f / lt;
#pragma unroll
    for (int b = 0; b < HD / 32; ++b)
#pragma unroll
        for (int g = 0; g < 4; ++g) { u32x2 w; w.x = pk2(st.o[b][4 * g] * inv, st.o[b][4 * g + 1] * inv); w.y = pk2(st.o[b][4 * g + 2] * inv, st.o[b][4 * g + 3] * inv); *(u32x2*)(yq + 32 * b + 8 * g) = w; }
}

__device__ __forceinline__ void fetch_tile128(LAS unsigned char* wb, const bf16_t* kt, unsigned ldk, const bf16_t* vt, unsigned ldv, int lane) {
    const unsigned a = (unsigned)lane >> 4, cl = (unsigned)lane & 15u;
    unsigned kvo[4];
#pragma unroll
    for (int i = 0; i < 4; ++i) kvo[i] = a * ldk * 2u + ((cl ^ ((4u * i + a) & 15u)) << 4);
#pragma unroll
    for (int i = 0; i < 8; ++i) {
        const int kp_c = 4 * ((i >> 1) & 1) + 8 * (i & 1) + 16 * (i >> 2);
        const char* kb_ = g8::uni_ptr((const char*)(kt + (size_t)kp_c * ldk));
        __builtin_amdgcn_global_load_lds((const unsigned*)(kb_ + kvo[i & 3]), (LAS unsigned*)(wb + i * 1024), 16, 0, 0);
    }
    const unsigned vvo = ((unsigned)lane >> 2) * ldv * 2u + ((((unsigned)lane & 3u) ^ (((unsigned)lane >> 4) & 3u)) << 4);
#pragma unroll
    for (int i = 0; i < 8; ++i) {
        const char* vb_ = g8::uni_ptr((const char*)(vt + (size_t)(16 * i) * ldv));
        __builtin_amdgcn_global_load_lds((const unsigned*)(vb_ + vvo), (LAS unsigned*)(wb + 8192 + i * 1024), 16, 0, 0);
    }
}
__device__ __forceinline__ void fetch_part128(LAS unsigned char* sb, const bf16_t* kt, unsigned ldk, const bf16_t* vt, unsigned ldv, int lane, int i) {
    const unsigned a = (unsigned)lane >> 4, cl = (unsigned)lane & 15u;
    const unsigned kvo = a * ldk * 2u + ((cl ^ ((4u * (unsigned)i + a) & 15u)) << 4);
    const int kp_c = 4 * ((i >> 1) & 1) + 8 * (i & 1) + 16 * (i >> 2);
    const char* kb_ = g8::uni_ptr((const char*)(kt + (size_t)kp_c * ldk));
    __builtin_amdgcn_global_load_lds((const unsigned*)(kb_ + kvo), (LAS unsigned*)(sb + i * 1024), 16, 0, 0);
    const unsigned vvo = ((unsigned)lane >> 2) * ldv * 2u + ((((unsigned)lane & 3u) ^ (((unsigned)lane >> 4) & 3u)) << 4);
    const char* vb_ = g8::uni_ptr((const char*)(vt + (size_t)(16 * i) * ldv));
    __builtin_amdgcn_global_load_lds((const unsigned*)(vb_ + vvo), (LAS unsigned*)(sb + 8192 + i * 1024), 16, 0, 0);
}
__device__ __forceinline__ void read_tile128(bf16x8 (&kf)[8], bf16x8 (&vf)[4][2], const LAS unsigned char* wb, int r, int h) {
    const LAS unsigned char* kr = wb + r * 256; const int rx = r & 15;
#pragma unroll
    for (int kk = 0; kk < 8; ++kk) kf[kk] = *(const LAS bf16x8*)(kr + (((2 * kk + h) ^ rx) << 4));
    const LAS unsigned char* vr = wb + 8192 + r * 64; const int vx = (r >> 2) & 3;
#pragma unroll
    for (int b = 0; b < 4; ++b)
#pragma unroll
        for (int s2 = 0; s2 < 2; ++s2) vf[b][s2] = *(const LAS bf16x8*)(vr + b * 2048 + (((2 * s2 + h) ^ vx) << 4));
}

__device__ __forceinline__ void fetch_k128(LAS unsigned char* wb, const bf16_t* kt, unsigned ldk, int lane) {
    const unsigned a = (unsigned)lane >> 4, cl = (unsigned)lane & 15u;
    unsigned kvo[4];
#pragma unroll
    for (int i = 0; i < 4; ++i) kvo[i] = a * ldk * 2u + ((cl ^ ((4u * i + a) & 15u)) << 4);
#pragma unroll
    for (int i = 0; i < 8; ++i) {
        const int kp_c = 4 * ((i >> 1) & 1) + 8 * (i & 1) + 16 * (i >> 2);
        const char* kb_ = g8::uni_ptr((const char*)(kt + (size_t)kp_c * ldk));
        __builtin_amdgcn_global_load_lds((const unsigned*)(kb_ + kvo[i & 3]), (LAS unsigned*)(wb + i * 1024), 16, 0, 0);
    }
}
__device__ __forceinline__ void fetch_v128(LAS unsigned char* wb, const bf16_t* vt, unsigned ldv, int lane) {
    const unsigned vvo = ((unsigned)lane >> 2) * ldv * 2u + ((((unsigned)lane & 3u) ^ (((unsigned)lane >> 4) & 3u)) << 4);
#pragma unroll
    for (int i = 0; i < 8; ++i) {
        const char* vb_ = g8::uni_ptr((const char*)(vt + (size_t)(16 * i) * ldv));
        __builtin_amdgcn_global_load_lds((const unsigned*)(vb_ + vvo), (LAS unsigned*)(wb + 8192 + i * 1024), 16, 0, 0);
    }
}
__device__ __forceinline__ void read_k128(bf16x8 (&kf)[8], const LAS unsigned char* wb, int r, int h) {
    const LAS unsigned char* kr = wb + r * 256; const int rx = r & 15;
#pragma unroll
    for (int kk = 0; kk < 8; ++kk) kf[kk] = *(const LAS bf16x8*)(kr + (((2 * kk + h) ^ rx) << 4));
}
__device__ __forceinline__ void read_v128(bf16x8 (&vf)[4][2], const LAS unsigned char* wb, int r, int h) {
    const LAS unsigned char* vr = wb + 8192 + r * 64; const int vx = (r >> 2) & 3;
#pragma unroll
    for (int b = 0; b < 4; ++b)
#pragma unroll
        for (int s2 = 0; s2 < 2; ++s2) vf[b][s2] = *(const LAS bf16x8*)(vr + b * 2048 + (((2 * s2 + h) ^ vx) << 4));
}
__device__ __forceinline__ void fetch_k192(LAS unsigned char* wb, const bf16_t* kt, unsigned ldk, int lane) {
#pragma unroll
    for (int i = 0; i < 12; ++i) {
        const unsigned p_ = 64u * i + (unsigned)lane, rho = p_ / 24u, cp = p_ - rho * 24u;
        const unsigned c = (cp & ~7u) | ((cp & 7u) ^ (rho & 7u)), kr = (rho & ~12u) | ((rho & 4u) << 1) | ((rho & 8u) >> 1);
        __builtin_amdgcn_global_load_lds((const unsigned*)((const char*)kt + (size_t)(kr * ldk * 2u + c * 16u)), (LAS unsigned*)(wb + i * 1024), 16, 0, 0);
    }
}
__device__ __forceinline__ void fetch_v192(LAS unsigned char* wb, const bf16_t* vt, unsigned ldv, int lane) {
    const unsigned vvo = ((unsigned)lane >> 2) * ldv * 2u + ((((unsigned)lane & 3u) ^ (((unsigned)lane >> 4) & 3u)) << 4);
#pragma unroll
    for (int i = 0; i < 12; ++i) {
        const char* vb_ = g8::uni_ptr((const char*)(vt + (size_t)(16 * i) * ldv));
        __builtin_amdgcn_global_load_lds((const unsigned*)(vb_ + vvo), (LAS unsigned*)(wb + i * 1024), 16, 0, 0);
    }
}
__device__ __forceinline__ void read_k192(bf16x8 (&kf)[12], const LAS unsigned char* wb, int r, int h) {
    const LAS unsigned char* kr = wb + r * 384; const int rx = r & 7;
#pragma unroll
    for (int kk = 0; kk < 12; ++kk) { const int c = 2 * kk + h; kf[kk] = *(const LAS bf16x8*)(kr + (((c & ~7) | ((c & 7) ^ rx)) << 4)); }
}
__device__ __forceinline__ void read_v192(bf16x8 (&vf)[6][2], const LAS unsigned char* wb, int r, int h) {
    const LAS unsigned char* vr = wb + r * 64; const int vx = (r >> 2) & 3;
#pragma unroll
    for (int b = 0; b < 6; ++b)
#pragma unroll
        for (int s2 = 0; s2 < 2; ++s2) vf[b][s2] = *(const LAS bf16x8*)(vr + b * 2048 + (((2 * s2 + h) ^ vx) << 4));
}
__device__ __forceinline__ void fetch_piece192(LAS unsigned char* sb, const bf16_t* kt, unsigned ldk, const bf16_t* vt, unsigned ldv, int lane, int idx) {
    if (idx < 12) {
        const unsigned p_ = 64u * (unsigned)idx + (unsigned)lane, rho = p_ / 24u, cp = p_ - rho * 24u;
        const unsigned c = (cp & ~7u) | ((cp & 7u) ^ (rho & 7u)), kr = (rho & ~12u) | ((rho & 4u) << 1) | ((rho & 8u) >> 1);
        __builtin_amdgcn_global_load_lds((const unsigned*)((const char*)kt + (size_t)(kr * ldk * 2u + c * 16u)), (LAS unsigned*)(sb + idx * 1024), 16, 0, 0);
    } else {
        const int i = idx - 12;
        const unsigned vvo = ((unsigned)lane >> 2) * ldv * 2u + ((((unsigned)lane & 3u) ^ (((unsigned)lane >> 4) & 3u)) << 4);
        const char* vb_ = g8::uni_ptr((const char*)(vt + (size_t)(16 * i) * ldv));
        __builtin_amdgcn_global_load_lds((const unsigned*)(vb_ + vvo), (LAS unsigned*)(sb + 12288 + i * 1024), 16, 0, 0);
    }
}
__device__ __forceinline__ void attn_store_lse(const AttnSt<128>& st, bf16_t* yq, float* lse, int h) {
    const float lt = st.l + __shfl_xor(st.l, 32); const float inv = 1.f / lt;
#pragma unroll
    for (int b = 0; b < 4; ++b)
#pragma unroll
        for (int g = 0; g < 4; ++g) { u32x2 w; w.x = pk2(st.o[b][4 * g] * inv, st.o[b][4 * g + 1] * inv); w.y = pk2(st.o[b][4 * g + 2] * inv, st.o[b][4 * g + 3] * inv); *(u32x2*)(yq + 32 * b + 8 * g) = w; }
    if (h == 0) *lse = st.m + __builtin_amdgcn_logf(lt);
}
struct MaskWin { int h, uq, u0;
    __device__ __forceinline__ bool operator()(int i, float& b) const { const int d = u0 + acc_key(i, h) - uq; b = 0.f; return (d <= 64) && (d >= -64); } };
struct MaskNone { __device__ __forceinline__ bool operator()(int, float& b) const { b = 0.f; return true; } };
struct MaskNA { int h, cq, c0, jk0; const LAS float* rp;
    __device__ __forceinline__ bool operator()(int i, float& b) const { const int jk = jk0 + acc_key(i, h); const bool ok = (jk >= c0) && (jk < c0 + 16); const int dc = ok ? (jk - cq + 15) : 0; b = rp[dc]; return ok; } };
struct MaskDil { int h, q, k0, dg;
    __device__ __forceinline__ bool operator()(int i, float& b) const { const int k = k0 + acc_key(i, h); const int d = k - q; b = 0.f; return (d <= 64 * dg) && (d >= -64 * dg) && ((d & (dg - 1)) == 0); } };

__device__ __forceinline__ void attn_phase(Frame& F, unsigned char* ws, int l, int qidx, int part = 0) {
    int lane_ = (int)threadIdx.x; asm volatile("" : "+v"(lane_)); lane_ &= 63;
    const int lane = lane_, r = lane & 31, h = lane >> 5, rk = kperm(r);
    LAS unsigned char* wb = F.lds + F.wave * 16384;
    const bf16_t* Z = (const bf16_t*)(ws + WS_Z); const bf16_t* VT = (const bf16_t*)(ws + WS_VT);
    const LAS float* rpb = (const LAS float*)(F.lds + XTAB_OFF);
    const bool tuned = (F.G == 256);
    const int xg = F.bx & 7, ar = tuned ? (F.bx - 96) >> 3 : 0;
    constexpr float SC128 = 0.08838834765f * 1.44269504f, SC192 = 0.07216878365f * 1.44269504f;
    (void)qidx;
    if (tuned && F.bx < 96) return;
    {
        const int w = F.wave;
        const int nbj = tuned ? (ar < 4 ? 3 : ar < 16 ? 4 : 3) : 0;
        for (int ji_ = 0, jp = tuned ? 0 : F.bx; part != 4 && (tuned ? ji_ < nbj : jp < 576); ++ji_, jp += F.G) {
            int pj;
            if (tuned) {
                if (ar < 4) pj = ji_ == 0 ? ar : ji_ == 1 ? 20 + ar : 40 + ar;
                else pj = ji_ == 0 ? ar : ji_ == 1 ? 24 + (ar - 4) : ji_ == 2 ? 56 + (ar - 4) : 40 + ar; }
            else pj = jp % 72;
            const int xq = tuned ? xg : jp / 72;
            __syncthreads();
            if (pj < 24) { const int jl = pj;
            const int grp = 3 * xq + (jl >> 3), R0 = 4 * (jl & 7), b = grp / 6, hd = grp % 6;
            const int gr = R0 + (w >> 1), half = w & 1;
            const int cq = 32 * half + r; int c0 = cq - 8; c0 = c0 < 0 ? 0 : (c0 > 48 ? 48 : c0);
            int r0q = gr - 4; r0q = r0q < 0 ? 0 : (r0q > 24 ? 24 : r0q);
            int krlo = R0 - 4; krlo = krlo < 0 ? 0 : (krlo > 24 ? 24 : krlo); int krhi = R0 - 1; krhi = (krhi < 0 ? 0 : (krhi > 24 ? 24 : krhi)) + 8;
            const int ntl = (krhi - krlo) * 2;
            const int tq = b * SEQ + gr * 64 + cq;
            bf16x8 qf[8], kf[8], vf[4][2];
            { const bf16_t* qp = Z + (size_t)tq * ZC + hd * 128 + 8 * h;
#pragma unroll
              for (int kk = 0; kk < 8; ++kk) qf[kk] = *(const bf16x8*)(qp + 16 * kk); }
            const bf16_t* kb = Z + (size_t)(b * SEQ + krlo * 64) * ZC + 768 + hd * 128;
            const bf16_t* vb = VT + (size_t)(hd * 128) * T + b * SEQ + krlo * 64;
#pragma unroll
            for (int t = 0; t < 3; ++t) fetch_part128(F.lds + t * 16384, kb + (size_t)(32 * t) * ZC, (unsigned)ZC, vb + 32 * t, (unsigned)T, lane, w);
            AttnSt<128> st; attn_init(st);
#pragma unroll 1
            for (int t = 0; t < ntl; ++t) {
                asm volatile("s_waitcnt vmcnt(4)" ::: "memory");
                __builtin_amdgcn_s_barrier();
                asm volatile("" ::: "memory");
                { const int tn = t + 3 < ntl ? t + 3 : ntl - 1;
                  fetch_part128(F.lds + ((t + 3) & 3) * 16384, kb + (size_t)(32 * tn) * ZC, (unsigned)ZC, vb + 32 * tn, (unsigned)T, lane, w); }
                const int kr = krlo + (t >> 1);
                if (kr >= r0q && kr < r0q + 8) {
                    read_tile128(kf, vf, F.lds + (t & 3) * 16384, r, h);
                    LDS_WAIT();
                    const f32x16 x = attn_qk<128>(kf, qf);
                    MaskNA mf{h, cq, c0, 32 * (t & 1), rpb + (hd * 15 + (kr - gr + 7)) * 31};
                    attn_pv<128>(st, x, vf, SC128, mf);
                }
            }
            attn_store<128>(st, (bf16_t*)(ws + WS_YA) + (size_t)tq * 768 + hd * 128 + 4 * h);
            } else if (pj >= 56) {
                const int mj = xq * 16 + (pj - 56), q8 = mj & 7, hd = (mj >> 3) & 3, b = mj >> 5;
                const int tq = b * SEQ + q8 * 256 + w * 32 + r;
                bf16x8 qf[12];
                { const bf16_t* qp = Z + (size_t)tq * ZC + 3072 + hd * 192 + 8 * h;
#pragma unroll
                  for (int kk = 0; kk < 12; ++kk) qf[kk] = *(const bf16x8*)(qp + 16 * kk); }
                const bf16_t* kb = (const bf16_t*)(ws + WS_KM) + (size_t)(b * MEML) * 768 + hd * 192;
                const bf16_t* vb = (const bf16_t*)(ws + WS_VMT) + (size_t)(hd * 192) * 1024 + b * MEML;
#pragma unroll
                for (int t = 0; t < 3; ++t)
#pragma unroll
                    for (int k3 = 0; k3 < 3; ++k3) fetch_piece192(F.lds + t * 24576, kb + (size_t)(32 * t) * 768, 768u, vb + 32 * t, 1024u, lane, w + 8 * k3);
                AttnSt<192> st; attn_init(st);
#pragma unroll 1
                for (int t = 0; t < 8; ++t) {
                    asm volatile("s_waitcnt vmcnt(6)" ::: "memory");
                    __builtin_amdgcn_s_barrier();
                    asm volatile("" ::: "memory");
                    { const int tn = t + 3 < 8 ? t + 3 : 7;
#pragma unroll
                      for (int k3 = 0; k3 < 3; ++k3) fetch_piece192(F.lds + ((t + 3) & 3) * 24576, kb + (size_t)(32 * tn) * 768, 768u, vb + 32 * tn, 1024u, lane, w + 8 * k3); }
                    const LAS unsigned char* sb = F.lds + (t & 3) * 24576;
                    f32x16 x;
                    { bf16x8 kf[12];
                      read_k192(kf, sb, r, h); LDS_WAIT();
#pragma unroll
                      for (int i = 0; i < 16; ++i) x[i] = 0.f;
#pragma unroll
                      for (int kk = 0; kk < 12; ++kk) x = MFMA32(kf[kk], qf[kk], x); }
                    MaskNone mf; bf16x8 xs[2];
                    const float alpha = attn_softmax<192>(st, x, SC192, mf, xs);
                    bf16x8 vf[6][2];
                    read_v192(vf, sb + 12288, r, h); LDS_WAIT();
                    attn_pvmm<192>(st, vf, xs, alpha);
                }
                attn_store<192>(st, (bf16_t*)(ws + WS_YM) + (size_t)tq * 768 + hd * 192 + 4 * h);
            } else {
                const int b = xq >> 1, hh = xq & 1, di = pj - 24;
                const int g = di < 8 ? 0 : di < 16 ? 1 : 2; const int dg = g == 0 ? 1 : g == 1 ? 4 : 16, sl = g == 0 ? 2048 : g == 1 ? 512 : 128;
                const int cls = g == 0 ? 0 : g == 1 ? ((di - 8) >> 1) : (di - 16), q8 = g == 0 ? di : g == 1 ? ((di - 8) & 1) : 0;
                const int hd = g * 2 + hh, qt = 8 * q8 + w; const bool active = 32 * qt < sl;
                const int uq = 32 * qt + r, tq = b * SEQ + cls + dg * (active ? uq : 0);
                int ulo = 256 * q8 - 64; if (ulo < 0) ulo = 0; int uhi = 256 * q8 + 320; if (uhi > sl) uhi = sl; const int ntl = (uhi - ulo) >> 5;
                bf16x8 qf[8], kf[8], vf[4][2];
                { const bf16_t* qp = Z + (size_t)tq * ZC + 1536 + hd * 128 + 8 * h;
#pragma unroll
                  for (int kk = 0; kk < 8; ++kk) qf[kk] = *(const bf16x8*)(qp + 16 * kk); }
                const bf16_t* kb = Z + (size_t)(b * SEQ + cls + dg * ulo) * ZC + 2304 + hd * 128;
                const bf16_t* vb = VT + (size_t)(768 + hd * 128) * T + b * SEQ + cls * sl + ulo;
#pragma unroll
                for (int t = 0; t < 3; ++t) fetch_part128(F.lds + t * 16384, kb + (size_t)(32 * t * dg) * ZC, (unsigned)(dg * ZC), vb + 32 * t, (unsigned)T, lane, w);
                AttnSt<128> st; attn_init(st);
#pragma unroll 1
                for (int t = 0; t < ntl; ++t) {
                    asm volatile("s_waitcnt vmcnt(4)" ::: "memory");
                    __builtin_amdgcn_s_barrier();
                    asm volatile("" ::: "memory");
                    { const int tn = t + 3 < ntl ? t + 3 : ntl - 1;
                      fetch_part128(F.lds + ((t + 3) & 3) * 16384, kb + (size_t)(32 * tn * dg) * ZC, (unsigned)(dg * ZC), vb + 32 * tn, (unsigned)T, lane, w); }
                    const int u0 = ulo + 32 * t;
                    if (active && u0 >= 32 * qt - 64 && u0 <= 32 * qt + 64) {
                        read_tile128(kf, vf, F.lds + (t & 3) * 16384, r, h);
                        LDS_WAIT();
                        const f32x16 x = attn_qk<128>(kf, qf);
                        MaskWin mf{h, uq, u0};
                        attn_pv<128>(st, x, vf, SC128, mf);
                    }
                }
                if (active) attn_store_lse(st, (bf16_t*)(ws + WS_OD) + ((size_t)(tq * 3 + g) * 2 + hh) * 128 + 4 * h, (float*)(ws + WS_LSE) + (size_t)(tq * 3 + g) * 2 + hh, h);
            }
        }
        VM_WAIT(); __syncthreads();
    }
}

constexpr int NPHASE = 21;

#ifndef PHASE_MASK
#define PHASE_MASK 0x1fffff
#endif
#define GRID_BAR() do { if (N_LAUNCHES == 1) xcd_barrier(bar); } while (0)
#define IN(k) ((((PHASE_MASK) >> ((k) % 32)) & 1) && lo <= (k) && (k) < hi)
#define BOTH(k) (IN(k) && IN((k) + 1))
#if defined(PROBE_A)
#define CW_STAMP 16384
#define STAMP(k) do { if (F.bx == 0 && F.tid == 0) ((volatile unsigned long long*)((unsigned*)(GAS unsigned*)(kargs()->ws + WS_CTL) + CW_STAMP))[(k)] = __builtin_amdgcn_s_memrealtime(); } while (0)
#else
#define STAMP(k) do { } while (0)
#endif
#define PHASE_END(k) do { if (BOTH(k)) { GRID_BAR(); STAMP((k) + 1); } } while (0)
#define PHASE_ENV() KArgsPtr ka = kargs(); unsigned char* ws = (unsigned char*)(GAS unsigned char*)ka->ws; int lane_ = (int)threadIdx.x; asm volatile("" : "+v"(lane_)); lane_ &= 63; const int gw = F.bx * NWAVES + F.wave, NGW = F.G * NWAVES, lane = lane_; (void)gw; (void)NGW; (void)lane
template <int l, int REP> __device__ __forceinline__ void mixer_phases(Frame& F, const XcdBarrier& bar, const int lo, const int hi) {
        const int pb = 1 + 9 * l;
        if (IN(pb)) {
            PHASE_ENV();
            SchedP1 S; S.G = F.G; S.c = F.bx; S.l = l; S.ws = ws;
            constexpr bool P1F8 = (F8_P1 != 0) && l == 1, G0F8 = (F8_G0 != 0) && l == 0;
            const bool conv = G0F8 && REP == 0 && F.G == 256;
            if (conv) S.G = 256 - CONV_WG;
            constexpr int CW1 = 32, CQ1 = 96, N1T = N_DEF1 - CW1 * NWAVES * CQ1, CT1 = ((N1T + (256 - CW1 - FILL1_BLK0) * NWAVES - 1) / ((256 - CW1 - FILL1_BLK0) * NWAVES) + 1) & ~1;
            static_assert(N1T > 0, "layer 1 conversion split");
            const bool conv1 = P1F8 && REP == 0 && F.G == 256;
            if (conv1) S.G = 256 - CW1;
            if (conv && F.bx >= 256 - CONV_WG) { const int w = (F.bx - (256 - CONV_WG)) * NWAVES + F.wave, first = w * CONV_CH, cnt = N_DEF1A - first < CONV_CH ? N_DEF1A - first : CONV_CH;
                if (cnt >= 2) cvt_fill(F, first, cnt); }
            else if (conv1 && F.bx >= 256 - CW1) cvt_fill(F, N_DEF1A + ((F.bx - (256 - CW1)) * NWAVES + F.wave) * CQ1, CQ1);
            else
            if constexpr (G0F8) {
                { S.part = 0; EpiP1T<false> E; E.bgate = ((const float*)(GAS const float*)ka->in[12]) + (size_t)l * 8192; E.rope = (const f32x2*)(ws + WS_TAB);
                  const UnitTab UT_ = build_units(F.lds, S); g8::gemm_phase<EpiP1T<false>, UnitTab, false>(F.lds, UT_, E); }
                { KArgsPtr kc = kargs(); S.part = 1; EpiP1T<true> E; E.bgate = ((const float*)(GAS const float*)kc->in[12]) + (size_t)l * 8192; E.rope = (const f32x2*)(ws + WS_TAB);
                  const UnitTab UT_ = build_units(F.lds, S); g8::gemm_phase<EpiP1T<true>, UnitTab, true>(F.lds, UT_, E); }
            } else {
            EpiP1T<P1F8> E; E.bgate = ((const float*)(GAS const float*)ka->in[12]) + (size_t)l * 8192; E.rope = (const f32x2*)(ws + WS_TAB);
            { const UnitTab UT_ = build_units(F.lds, S); g8::gemm_phase<EpiP1T<P1F8>, UnitTab, P1F8>(F.lds, UT_, E); }
            }
            if (conv1 && F.bx >= FILL1_BLK0 && F.bx < 256 - CW1) { const int w = (F.bx - FILL1_BLK0) * NWAVES + F.wave, first = w * CT1, cnt = N1T - first < CT1 ? N1T - first : CT1; if (cnt >= 2) cvt_fill(F, N_DEF1A + CW1 * NWAVES * CQ1 + first, cnt); }
            PHASE_END(pb);
        }
        if (IN(pb + 1)) {
            PHASE_ENV();
            { LAS float* rpb = (LAS float*)(F.lds + XTAB_OFF); const float* src = ((const float*)(GAS const float*)ka->in[4]) + (size_t)l * 2790; for (int i = F.tid; i < 2790; i += NTHREADS) rpb[i] = src[i] * 1.44269504f; }
            __syncthreads();
#ifndef REPEAT_SUB
#define REPEAT_SUB 0
#endif
            if (!(REP == 1 && REPEAT_SUB >= 2)) { SchedDFT S; S.c = F.bx; S.ws = ws;
              EpiPlain E;
              { const UnitTab UT_ = build_units(F.lds, S); g8::gemm_phase<EpiPlain, UnitTab>(F.lds, UT_, E); } }
            if (!(REP == 1 && REPEAT_SUB == 1)) attn_phase(F, ws, l, l + 2 * REP, (REP == 1 && REPEAT_SUB >= 3) ? REPEAT_SUB : 0);
            if (REP == 0 && F.G == 256 && F.bx >= 96) { __syncthreads(); cvt_fill(F, CV_I_EXP - N_DEFER + N_DEF1A + N_DEF1 + N_DEF3 + l * N_DEF2 + ((F.bx - 96) * NWAVES + F.wave) * N_FILL2, N_FILL2); }
            PHASE_END(pb + 1);
        }
        if (IN(pb + 2)) {
            PHASE_ENV();
            const int hh = lane >> 5, d4 = (lane & 31) * 4;
            auto comb = [&](float l0, float l1, float l2, u32x2 a, u32x2 b_, u32x2 c, int it) {
                const float mx = fmaxf(l0, fmaxf(l1, l2)); const float e0 = __builtin_amdgcn_exp2f(l0 - mx), e1 = __builtin_amdgcn_exp2f(l1 - mx), e2 = __builtin_amdgcn_exp2f(l2 - mx); const float inv = 1.f / (e0 + e1 + e2);
                const float w0 = e0 * inv, w1 = e1 * inv, w2 = e2 * inv;
                u32x2 o; o.x = pk2(w0 * bf_lo(a.x) + w1 * bf_lo(b_.x) + w2 * bf_lo(c.x), w0 * bf_hi(a.x) + w1 * bf_hi(b_.x) + w2 * bf_hi(c.x));
                o.y = pk2(w0 * bf_lo(a.y) + w1 * bf_lo(b_.y) + w2 * bf_lo(c.y), w0 * bf_hi(a.y) + w1 * bf_hi(b_.y) + w2 * bf_hi(c.y));
                *(u32x2*)((bf16_t*)(ws + WS_YC) + (size_t)it * 256 + hh * 128 + d4) = o; };
            if (4 * NGW == T) {
                float ll[4][3]; u32x2 q[4][3];
#pragma unroll
                for (int k = 0; k < 4; ++k) { const int it = gw + k * NGW; const float* ls = (const float*)(ws + WS_LSE) + (size_t)it * 6 + hh; ll[k][0] = ls[0]; ll[k][1] = ls[2]; ll[k][2] = ls[4];
                    const bf16_t* od = (const bf16_t*)(ws + WS_OD) + ((size_t)it * 6 + hh) * 128 + d4; q[k][0] = *(const u32x2*)od; q[k][1] = *(const u32x2*)(od + 256); q[k][2] = *(const u32x2*)(od + 512); }
#pragma unroll
                for (int k = 0; k < 4; ++k) comb(ll[k][0], ll[k][1], ll[k][2], q[k][0], q[k][1], q[k][2], gw + k * NGW);
            } else
            for (int it = gw; it < T; it += NGW) {
                const float* ls = (const float*)(ws + WS_LSE) + (size_t)it * 6 + hh; const float l0 = ls[0], l1 = ls[2], l2 = ls[4];
                const bf16_t* od = (const bf16_t*)(ws + WS_OD) + ((size_t)it * 6 + hh) * 128 + d4;
                const u32x2 a = *(const u32x2*)od, b_ = *(const u32x2*)(od + 256), c = *(const u32x2*)(od + 512);
                comb(l0, l1, l2, a, b_, c, it);
            }
            PHASE_END(pb + 2);
        }
        if (IN(pb + 3)) {
            PHASE_ENV();
            SchedP3 S; S.G = F.G; S.c = F.bx; S.l = l; S.ws = ws;
            EpiBranch E; E.G = (const char*)(ws + WS_G); E.PB = (char*)(ws + WS_MP); E.MG = (bf16_t*)(ws + WS_MG);
            { const UnitTab UT_ = build_units(F.lds, S); g8::gemm_phase<EpiBranch, UnitTab>(F.lds, UT_, E); }
            PHASE_END(pb + 3);
        }
        if (IN(pb + 4)) {
            PHASE_ENV();
            SchedSimple S; S.G = F.G; S.c = F.bx; S.A = (const char*)(ws + WS_MG); S.B = (const char*)(ws + WS_WO) + (size_t)l * D * D * 2; S.lda2 = 4096; S.ldb2 = 4096; S.nM = 32; S.nN = 8; S.nt = 32; S.colmul = 256;
            EpiResid E; E.Xin = (l == 0) ? ((const float*)(GAS const float*)ka->in[0]) : (const float*)(ws + WS_X); E.Xout = (float*)(ws + WS_X); E.ldc = D;
            { const UnitTab UT_ = build_units(F.lds, S); g8::gemm_phase<EpiResid, UnitTab>(F.lds, UT_, E); }
            PHASE_END(pb + 4);
        }
}
__device__ __forceinline__ void dense_ffn_phases(Frame& F, const XcdBarrier& bar, const int lo, const int hi) {
            if (IN(6)) { PHASE_ENV(); const float* gain = ((const float*)(GAS const float*)ka->in[14]); for (int it = gw; it < T; it += NGW) rms_row_bf16((const float*)(ws + WS_X) + (size_t)it * D, gain, (bf16_t*)(ws + WS_H) + (size_t)it * D, lane); PHASE_END(6); }
            if (IN(7)) {
                PHASE_ENV();
                constexpr int CW7 = 32, CH7L = ((I_LAYER + CW7 * NWAVES - 1) / (CW7 * NWAVES) + 1) & ~1, CH7E = 32, N7E = CW7 * NWAVES * CH7E, N7T = N_DEF3 - N7E, CH7T = ((N7T + 160 * NWAVES - 1) / (160 * NWAVES) + 1) & ~1;
                static_assert(N7T > 0 && N7E % 2 == 0, "dense gate/up conversion split");
                const bool conv7 = F.G == 256; constexpr int base3 = CV_I_EXP - N_DEFER + N_DEF1A + N_DEF1;
                SchedSimple S; S.G = conv7 ? 256 - CW7 : F.G; S.c = F.bx; S.A = (const char*)(ws + WS_H); S.B = (const char*)(ws + WS_DGU); S.lda2 = 4096; S.ldb2 = 4096; S.nM = 32; S.nN = 44; S.nt = 32; S.colmul = 128;
                if (conv7 && F.bx >= 256 - CW7) { const int w = (F.bx - (256 - CW7)) * NWAVES + F.wave;
                    { const int first = w * CH7L, cnt = I_LAYER - first < CH7L ? I_LAYER - first : CH7L; if (cnt >= 2) cvt_fill<true>(F, NITEMS - I_LAYER + first, cnt); }
                    { const int first = w * CH7E; cvt_fill(F, base3 + first, CH7E); }
                } else {
                EpiSwigluT<false> E; S.O = (char*)(ws + WS_ACT);
                { const UnitTab UT_ = build_units(F.lds, S); g8::gemm_phase<EpiSwigluT<false>, UnitTab>(F.lds, UT_, E); }
                if (conv7 && F.bx >= 64) { const int w = (F.bx - 64) * NWAVES + F.wave, first = w * CH7T, cnt = N7T - first < CH7T ? N7T - first : CH7T; if (cnt >= 2) cvt_fill(F, base3 + N7E + first, cnt); }
                }
                PHASE_END(7);
            }
            if (IN(8)) {
                PHASE_ENV();
                SchedSimple S; S.G = F.G; S.c = F.bx; S.A = (const char*)(ws + WS_ACT); S.B = (const char*)(ws + WS_DD); S.lda2 = F8_DFD ? DFF : DFF * 2; S.ldb2 = S.lda2; S.nM = 32; S.nN = 8; S.nt = F8_DFD ? DFF / 128 : DFF / 64; S.colmul = 256;
                EpiResidT<(F8_DFD != 0)> E; E.Xin = (const float*)(ws + WS_X); E.Xout = (float*)(ws + WS_X); E.ldc = D;
                { const UnitTab UT_ = build_units(F.lds, S); g8::gemm_phase<EpiResidT<(F8_DFD != 0)>, UnitTab, (F8_DFD != 0)>(F.lds, UT_, E); }
                PHASE_END(8);
            }
            if (IN(9)) { PHASE_ENV(); const float* gain = ((const float*)(GAS const float*)ka->in[2]) + D; for (int it = gw; it < T; it += NGW) { if (F8_P1) rms_row_f8((const float*)(ws + WS_X) + (size_t)it * D, gain, (unsigned char*)(ws + WS_H) + (size_t)it * D, lane); else rms_row_bf16((const float*)(ws + WS_X) + (size_t)it * D, gain, (bf16_t*)(ws + WS_H) + (size_t)it * D, lane); } PHASE_END(9); }
}
__device__ __forceinline__ void moe_ffn_phases(Frame& F, const XcdBarrier& bar, const int lo, const int hi) {
            if (IN(15)) {
                PHASE_ENV();
                const float* rt = ((const float*)(GAS const float*)ka->in[18]); const float* gain = ((const float*)(GAS const float*)ka->in[14]) + D;
                LAS float* Rt = (LAS float*)(F.lds + 4096);
                for (int k = F.tid; k < D; k += NTHREADS) { const f32x4 r0 = ((const f32x4*)rt)[2 * k], r1 = ((const f32x4*)rt)[2 * k + 1];
                    Rt[0 * D + k] = r0.x; Rt[1 * D + k] = r0.y; Rt[2 * D + k] = r0.z; Rt[3 * D + k] = r0.w; Rt[4 * D + k] = r1.x; Rt[5 * D + k] = r1.y; Rt[6 * D + k] = r1.z; Rt[7 * D + k] = r1.w; }
                __syncthreads();
                for (int it = gw; it < T; it += NGW) {
                    const f32x4* xr = (const f32x4*)((const float*)(ws + WS_X) + (size_t)it * D) + lane; const f32x4* gr = (const f32x4*)gain + lane;
                    f32x4 v[8]; float s = 0.f;
#pragma unroll
                    for (int j = 0; j < 8; ++j) { v[j] = xr[64 * j]; s += (v[j].x * v[j].x + v[j].y * v[j].y) + (v[j].z * v[j].z + v[j].w * v[j].w); }
                    const float rstd = __builtin_amdgcn_rsqf(wave_sum(s) * (1.f / D) + RMS_EPS);
                    float lg[8];
#pragma unroll
                    for (int e = 0; e < 8; ++e) lg[e] = 0.f;
                    unsigned* o8 = (unsigned*)((unsigned char*)(ws + WS_H) + (size_t)it * D) + lane;
                    u32x2* o16 = (u32x2*)((bf16_t*)(ws + WS_H) + (size_t)it * D) + lane;
#pragma unroll
                    for (int j = 0; j < 8; ++j) { const f32x4 g = gr[64 * j]; v[j].x *= rstd * g.x; v[j].y *= rstd * g.y; v[j].z *= rstd * g.z; v[j].w *= rstd * g.w;
                        if (F8_GU) { const float q = (float)(1 << F8S_H); o8[64 * j] = pk4f8(v[j].x * q, v[j].y * q, v[j].z * q, v[j].w * q); }
                        else { u32x2 w; w.x = pk2(v[j].x, v[j].y); w.y = pk2(v[j].z, v[j].w); o16[64 * j] = w; } }
#pragma unroll
                    for (int j = 0; j < 8; ++j) { const f32x4 hv = v[j];
                        asm volatile("" ::: "memory");
#pragma unroll
                        for (int e = 0; e < 8; ++e) { const f32x4 r = *(const LAS f32x4*)(Rt + e * D + 4 * (lane + 64 * j));
                            lg[e] += hv.x * r.x; lg[e] += hv.y * r.y; lg[e] += hv.z * r.z; lg[e] += hv.w * r.w; } }
#pragma unroll
                    for (int e = 0; e < 8; ++e) lg[e] = wave_sum(lg[e]);
                    if (lane == 0) {
                        int e1 = 0; float v1 = lg[0];
#pragma unroll
                        for (int e = 1; e < 8; ++e) if (lg[e] > v1) { v1 = lg[e]; e1 = e; }
                        int e2 = -1; float v2 = -3.0e38f;
#pragma unroll
                        for (int e = 0; e < 8; ++e) if (e != e1 && lg[e] > v2) { v2 = lg[e]; e2 = e; }
                        const float p2 = __expf(v2 - v1), w1 = 1.f / (1.f + p2), w2 = p2 / (1.f + p2);
                        ((int*)(ws + WS_TOKE))[2 * it] = e1; ((int*)(ws + WS_TOKE))[2 * it + 1] = e2;
                        { const int li = (((it - gw) / NGW) * NWAVES + F.wave) * 2; LAS int* el = (LAS int*)(F.lds); if (li < 64) { el[li] = e1; el[li + 1] = e2; } }
                        ((float*)(ws + WS_TOKW))[2 * it] = w1; ((float*)(ws + WS_TOKW))[2 * it + 1] = w2;
                    }
                }
                if (F.G == 256) {
                    __syncthreads();
                    LAS int* el = (LAS int*)(F.lds); const int t = F.tid;
                    if (t < 64) { const int e = el[t]; int lr = 0;
                        for (int j = 0; j < 64; ++j) lr += (j < t && el[j] == e) ? 1 : 0;
                        const int k = t >> 4, w = (t >> 1) & 7, kk = t & 1, tok = (F.bx * NWAVES + w) + k * NGW;
                        ((int*)(ws + WS_RANK))[2 * tok + kk] = lr; }
                    else if (t < 72) { const int e = t - 64; int c = 0;
                        for (int j = 0; j < 64; ++j) c += (el[j] == e) ? 1 : 0;
                        ((int*)(ws + WS_CTL))[CW_HIST + F.bx * 8 + e] = c; }
                }
                PHASE_END(15);
            }
            if (IN(16)) {
                PHASE_ENV();
                if (F.G != 256 && F.bx < 8) {
                    const int e = F.bx; const int* te = (const int*)(ws + WS_TOKE); int* rk = (int*)(ws + WS_RANK);
                    LAS int* wsum = (LAS int*)(F.lds);
                    int base = 0;
                    for (int c0 = 0; c0 < 2 * T; c0 += NTHREADS) {
                        const int idx = c0 + F.tid; const bool hit = te[idx] == e;
                        const unsigned long long bal = __ballot(hit);
                        const int pre = __popcll(bal & ((1ull << lane) - 1ull)), tot = __popcll(bal);
                        __syncthreads();
                        if (lane == 0) wsum[F.wave] = tot;
                        __syncthreads();
                        int woff = 0, all = 0;
#pragma unroll
                        for (int w = 0; w < 8; ++w) { const int t = wsum[w]; if (w < F.wave) woff += t; all += t; }
                        if (hit) rk[idx] = base + woff + pre;
                        base += all;
                    }
                    if (F.tid == 0) ((int*)(ws + WS_CTL))[CW_MOE + e] = base;
                }
                if (BOTH(16) && F.G != 256) { GRID_BAR(); }
            }
            if (IN(17)) {
                PHASE_ENV();
                const bool fast = F.G == 256;
                LAS int* H = (LAS int*)(F.lds); LAS int* tot = H + 2048;
                if (fast) {
                    ((LAS i32x4*)H)[F.tid] = ((const i32x4*)((const int*)(ws + WS_CTL) + CW_HIST))[F.tid];
                    __syncthreads();
                    { const int e = F.wave; int v[4], sm = 0;
#pragma unroll
                      for (int j = 0; j < 4; ++j) { v[j] = H[(4 * lane + j) * 8 + e]; sm += v[j]; }
                      int incl = sm;
#pragma unroll
                      for (int o = 1; o < 64; o <<= 1) { const int u_ = __shfl_up(incl, o); if (lane >= o) incl += u_; }
                      int ex = incl - sm;
#pragma unroll
                      for (int j = 0; j < 4; ++j) { H[(4 * lane + j) * 8 + e] = ex; ex += v[j]; }
                      if (lane == 63) tot[e] = incl; }
                    __syncthreads();
                    if (F.bx == 0 && F.tid < 8) ((int*)(ws + WS_CTL))[CW_MOE + F.tid] = tot[F.tid];
                }
                int off[8]; { int a = 0;
#pragma unroll
                    for (int e = 0; e < 8; ++e) { off[e] = a; a += fast ? tot[e] : ((const int*)(ws + WS_CTL))[CW_MOE + e]; } }
                for (int it = gw; it < 2 * T; it += NGW) {
                    const int e = ((const int*)(ws + WS_TOKE))[it], rk = ((const int*)(ws + WS_RANK))[it];
                    int o = 0;
#pragma unroll
                    for (int q = 0; q < 8; ++q) o = (e == q) ? off[q] : o;
                    const int slot = o + rk + (fast ? H[((((it >> 1) & (NGW - 1)) >> 3) * 8) + e] : 0);
                    if (lane == 0) ((int*)(ws + WS_TOKS))[it] = slot;
                    constexpr int RB = F8_GU ? D : 2 * D;
                    const u32x4* src = (const u32x4*)((const unsigned char*)(ws + WS_H) + (size_t)(it >> 1) * RB) + lane; u32x4* dst = (u32x4*)((unsigned char*)(ws + WS_HA) + (size_t)slot * RB) + lane;
#pragma unroll
                    for (int j = 0; j < RB / 1024; ++j) dst[64 * j] = src[64 * j];
                }
                PHASE_END(17);
            }
            if (IN(18)) {
                PHASE_ENV();
                SchedMoe S; S.G = F.G; S.c = F.bx; S.A = (const char*)(ws + WS_HA); S.B = (const char*)(ws + WS_EGU); S.lda2 = F8_GU ? 2048 : 4096; S.ldb2 = S.lda2; S.wstride = (size_t)14336 * S.lda2; S.nN = 56; S.nt = F8_GU ? 16 : 32; S.colmul = 128;
                S.cntp = (const int*)(ws + WS_CTL) + CW_MOE;
                EpiSwigluT<true> E; S.O = (char*)(ws + WS_EACT);
                { const UnitTab UT_ = build_units(F.lds, S); g8::gemm_phase<EpiSwigluT<true>, UnitTab, (F8_GU != 0)>(F.lds, UT_, E); }
                PHASE_END(18);
            }
            if (IN(19)) {
                PHASE_ENV();
                SchedMoeDown S; S.G = F.G; S.c = F.bx; S.A = (const char*)(ws + WS_EACT); S.B = (const char*)(ws + WS_ED); S.lda2 = F8_DN ? EFF : 2 * EFF; S.ldb2 = S.lda2; S.wstride = (size_t)D * S.lda2; S.ntu = F8_DN ? EFF / 128 : EFF / 64;
                S.cntp = (const int*)(ws + WS_CTL) + CW_MOE; S.O0 = (char*)(ws + WS_OS); S.PB = (char*)(ws + WS_OS1);
                EpiMoeDown E;
                { const UnitTab UT_ = build_units(F.lds, S); g8::gemm_phase<EpiMoeDown, UnitTab, (F8_DN != 0)>(F.lds, UT_, E); }
                PHASE_END(19);
            }
            if (IN(20)) {
                PHASE_ENV();
                const float* fgain = ((const float*)(GAS const float*)ka->in[22]); float* outp = (float*)(GAS float*)ka->out;
                MoeDownPlan P; moe_down_plan((const int*)(ws + WS_CTL) + CW_MOE, F.G, P);
                const int split_start = __builtin_amdgcn_readfirstlane(P.split_start), S_ = __builtin_amdgcn_readfirstlane(P.S), trows = __builtin_amdgcn_readfirstlane(P.trows);
                auto tokrow = [&](const int it, const int sl0, const int sl1, const float w0, const float w1) {
                    const f32x4* xr = (const f32x4*)((const float*)(ws + WS_X) + (size_t)it * D) + lane;
                    const f32x4* gr = (const f32x4*)fgain + lane;
                    f32x4 v[8];
#pragma unroll
                    for (int j = 0; j < 8; ++j) v[j] = xr[64 * j];
#pragma unroll
                    for (int k = 0; k < 2; ++k) {
                        const int sl = k == 0 ? sl0 : sl1; const float w = k == 0 ? w0 : w1;
                        if (sl < split_start) { const u32x2* o = (const u32x2*)((const bf16_t*)(ws + WS_OS) + (size_t)sl * D) + lane;
#pragma unroll
                            for (int j = 0; j < 8; ++j) { const u32x2 q = o[64 * j]; v[j].x += w * bf_lo(q.x); v[j].y += w * bf_hi(q.x); v[j].z += w * bf_lo(q.y); v[j].w += w * bf_hi(q.y); } }
                        else for (int p_ = 0; p_ < S_; ++p_) { const f32x4* o = (const f32x4*)((const float*)(ws + WS_OS1) + ((size_t)p_ * trows + (sl - split_start)) * D) + lane;
#pragma unroll
                            for (int j = 0; j < 8; ++j) v[j] += w * o[64 * j]; }
                    }
                    float s = 0.f;
#pragma unroll
                    for (int j = 0; j < 8; ++j) s += (v[j].x * v[j].x + v[j].y * v[j].y) + (v[j].z * v[j].z + v[j].w * v[j].w);
                    const float rstd = __builtin_amdgcn_rsqf(wave_sum(s) * (1.f / D) + RMS_EPS);
                    f32x4* orow = (f32x4*)(outp + (size_t)it * D) + lane;
#pragma unroll
                    for (int j = 0; j < 8; ++j) { const f32x4 g = gr[64 * j]; orow[64 * j] = v[j] * rstd * g; }
                };
                const int* tks = (const int*)(ws + WS_TOKS); const float* tkw = (const float*)(ws + WS_TOKW);
                if (4 * NGW == T) {
                    int sq[8]; float wq[8];
#pragma unroll
                    for (int k = 0; k < 4; ++k) { const int it = gw + k * NGW; sq[2 * k] = __builtin_amdgcn_readfirstlane(tks[2 * it]); sq[2 * k + 1] = __builtin_amdgcn_readfirstlane(tks[2 * it + 1]);
                        wq[2 * k] = __uint_as_float(__builtin_amdgcn_readfirstlane(__float_as_uint(tkw[2 * it]))); wq[2 * k + 1] = __uint_as_float(__builtin_amdgcn_readfirstlane(__float_as_uint(tkw[2 * it + 1]))); }
#pragma unroll
                    for (int k = 0; k < 4; ++k) tokrow(gw + k * NGW, sq[2 * k], sq[2 * k + 1], wq[2 * k], wq[2 * k + 1]);
                } else
                for (int it = gw; it < T; it += NGW) tokrow(it, __builtin_amdgcn_readfirstlane(tks[2 * it]), __builtin_amdgcn_readfirstlane(tks[2 * it + 1]), tkw[2 * it], tkw[2 * it + 1]);
            }
}
__global__ void __launch_bounds__(NTHREADS, 2) fwd_kernel(Args args) {
    extern __shared__ __attribute__((aligned(16))) unsigned char lds_raw[];
    Frame F;
    F.lds = (LAS unsigned char*)lds_raw; F.MISC = (volatile LAS unsigned*)(F.lds + MISC_OFF);
    F.tid = threadIdx.x; F.lane = F.tid & 63; F.wave = __builtin_amdgcn_readfirstlane(F.tid >> 6); F.G = gridDim.x; F.bx = blockIdx.x;
    if (F.tid < 64) ((LAS unsigned*)(F.lds + MISC_OFF))[F.tid] = 0u;
    __syncthreads();
    XcdBarrier bar; bar.bar = (unsigned*)(GAS unsigned*)(args.ws + WS_CTL) + CW_BAR; bar.x = 0; bar.st = nullptr;
    if (N_LAUNCHES == 1) bar = xcd_barrier_post((unsigned*)(GAS unsigned*)(args.ws + WS_CTL) + CW_BAR, F.MISC + 8);
    const int lo = args.ph_lo, hi = args.ph_hi;

    STAMP(0);

#ifndef REPEAT_PHASE
#define REPEAT_PHASE -1
#endif
    if (REPEAT_PHASE == 0 && N_LAUNCHES == 1) { p0_prologue(F); GRID_BAR(); }
    if (IN(0)) { p0_prologue(F); PHASE_END(0); }
    if (REPEAT_PHASE >= 1 && REPEAT_PHASE <= 4 && N_LAUNCHES == 1) { mixer_phases<0, 1>(F, bar, REPEAT_PHASE, REPEAT_PHASE + 1); GRID_BAR(); }
    mixer_phases<0, 0>(F, bar, lo, hi);
    if (REPEAT_PHASE == 7 && N_LAUNCHES == 1) { dense_ffn_phases(F, bar, 7, 8); GRID_BAR(); }
    dense_ffn_phases(F, bar, lo, hi);
    if (REPEAT_PHASE >= 1 && REPEAT_PHASE <= 4 && N_LAUNCHES == 1) { mixer_phases<1, 1>(F, bar, REPEAT_PHASE + 9, REPEAT_PHASE + 10); GRID_BAR(); }
    mixer_phases<1, 0>(F, bar, lo, hi);
    moe_ffn_phases(F, bar, lo, hi);
    if (REPEAT_PHASE >= 15 && REPEAT_PHASE <= 19 && N_LAUNCHES == 1) { GRID_BAR(); moe_ffn_phases(F, bar, REPEAT_PHASE, REPEAT_PHASE + 1); }
#if defined(PROBE_A)
    GRID_BAR(); STAMP(NPHASE);
    GRID_BAR();
    { KArgsPtr ka = kargs(); const volatile unsigned long long* st = (const volatile unsigned long long*)((unsigned*)(GAS unsigned*)(ka->ws + WS_CTL) + CW_STAMP);
      const float ta = (float)(st[PROBE_A + 1] - st[PROBE_A]) * 0.01f, tb = (float)(st[PROBE_B + 1] - st[PROBE_B]) * 0.01f;
      float* o = (float*)(GAS float*)ka->out; const float v1 = sqrtf(ta * 0.1f);
      int t_ = F.tid; asm volatile("" : "+v"(t_));
      for (size_t i = (size_t)F.bx * NTHREADS + t_; i < (size_t)T * D; i += (size_t)F.G * NTHREADS) o[i] = (i == 12345) ? tb : v1; }
#endif
}
#undef IN
#undef BOTH
#undef GRID_BAR
#undef PHASE_ENV

extern "C" void kernel_launch(void* const* d_in, const int* in_sizes, int n_in, void* d_out, int out_size, void* d_ws, size_t ws_size, hipStream_t stream) {
    static int grid = 0;
    if (grid == 0) {
        if (n_in != 23 || out_size != T * D || ws_size < WS_END) { fprintf(stderr, "kernel_launch: unexpected shapes (n_in %d out %d ws %zu need %zu)\n", n_in, out_size, ws_size, (size_t)WS_END); grid = -1; return; }
        int dev = 0, cus = 0, per_cu = 0;
        if (hipGetDevice(&dev) != hipSuccess || hipDeviceGetAttribute(&cus, hipDeviceAttributeMultiprocessorCount, dev) != hipSuccess) { grid = -1; return; }
        if (hipFuncSetAttribute((const void*)fwd_kernel, hipFuncAttributeMaxDynamicSharedMemorySize, LDS_BYTES) != hipSuccess) { fprintf(stderr, "kernel_launch: hipFuncSetAttribute failed\n"); grid = -1; return; }
        if (hipOccupancyMaxActiveBlocksPerMultiprocessor(&per_cu, (const void*)fwd_kernel, NTHREADS, LDS_BYTES) != hipSuccess || per_cu < 1) { fprintf(stderr, "kernel_launch: occupancy query says %d\n", per_cu); (void)hipGetLastError(); grid = -1; return; }
        grid = cus;
    }
    if (grid < 0) return;
    if (hipMemsetAsync((char*)d_ws + WS_CTL, 0, CTL_ZERO_BYTES, stream) != hipSuccess) return;
    Args a{};
    for (int i = 0; i < 23; ++i) a.in[i] = (const float*)d_in[i];
    a.out = (float*)d_out; a.ws = (unsigned char*)d_ws;
    if (N_LAUNCHES == 1) { a.ph_lo = 0; a.ph_hi = NPHASE; hipLaunchKernelGGL(fwd_kernel, dim3(grid), dim3(NTHREADS), LDS_BYTES, stream, a); }
    else for (int p = 0; p < NPHASE; ++p) { a.ph_lo = p; a.ph_hi = p + 1; hipLaunchKernelGGL(fwd_kernel, dim3(grid), dim3(NTHREADS), LDS_BYTES, stream, a); }
}
```
